# Optimizing an MI355X kernel written in HIP

```python
import math
import jax, jax.numpy as jnp
from jax import lax
import numpy as np

D_MODEL = 1024
BATCH = 16
SEQ = 4096
DEPTH = 4

CHUNK = 64
MEM_LEN = 256
N_MIXERS = 3
RMS_EPS = 1e-6
GN_EPS = 1e-5
POOL_WINDOWS = (2, 4, 8, 16)
POOL_GROUPS = len(POOL_WINDOWS)
POOL_GROUP_DIM = D_MODEL // POOL_GROUPS
SB_HEADS = 16
SB_HEAD_DIM = D_MODEL // SB_HEADS
SB_BLOCK = 128
RET_HEADS = D_MODEL // 256
RET_QK_DIM = D_MODEL // RET_HEADS
RET_V_DIM = 2 * D_MODEL // RET_HEADS
ROPE_BASE = 10000.0
XA_HEADS = 4
XA_HEAD_DIM = D_MODEL // XA_HEADS
D_FF = -(-8 * D_MODEL // (3 * 256)) * 256
N_POOL_LAYERS = (DEPTH + N_MIXERS - 1) // N_MIXERS
N_SB_LAYERS = (DEPTH - 1 + N_MIXERS - 1) // N_MIXERS
N_RET_LAYERS = (DEPTH - 2 + N_MIXERS - 1) // N_MIXERS

kernel_name = "hybrid_pool_stickbreak_retention_encoder"


def rms_norm(x, g):
    xf = x.astype(jnp.float32)
    y = xf * lax.rsqrt(jnp.mean(xf * xf, axis=-1, keepdims=True) + RMS_EPS)
    return (y * g.astype(jnp.float32)).astype(x.dtype)


def pool_mixer(h, w_grp, scale):
    B, S, D = h.shape
    hg = h.reshape(B, S, POOL_GROUPS, POOL_GROUP_DIM).astype(jnp.float32)
    csum = jnp.cumsum(hg, axis=1)
    t = jnp.arange(S)
    outs = []
    for g, w in enumerate(POOL_WINDOWS):
        c = csum[:, :, g]
        lagged = jnp.pad(c, ((0, 0), (w, 0), (0, 0)))[:, :S]
        count = jnp.minimum(t + 1, w).astype(jnp.float32)[None, :, None]
        outs.append((c - lagged) / count - hg[:, :, g])
    d = jnp.stack(outs, axis=2).astype(h.dtype)
    y = jnp.einsum('bsgc,gce->bsge', d, w_grp)
    return y.reshape(B, S, D) * scale


def stick_breaking_attention(h, w_in, w_out):
    B, S, D = h.shape
    q, k, v = jnp.split(h @ w_in, 3, axis=-1)
    def heads(a):
        return a.reshape(B, S, SB_HEADS, SB_HEAD_DIM).transpose(0, 2, 1, 3).astype(jnp.float32)
    q = heads(q) * (SB_HEAD_DIM ** -0.5)
    k = heads(k)
    v = heads(v)
    outs = []
    for start in range(0, S, SB_BLOCK):
        stop = start + SB_BLOCK
        qb = q[:, :, start:stop]
        kb = k[:, :, :stop]
        vb = v[:, :, :stop]
        z = jnp.einsum('bhtd,bhsd->bhts', qb, kb)
        before = jnp.arange(stop)[None, :] < jnp.arange(start, stop)[:, None]
        log_keep = jnp.where(before, jax.nn.log_sigmoid(-z), 0.0)
        tail = lax.cumsum(log_keep, axis=3, reverse=True) - log_keep
        a = jnp.where(before, jnp.exp(jax.nn.log_sigmoid(z) + tail), 0.0)
        outs.append(jnp.einsum('bhts,bhsd->bhtd', a, vb))
    o = jnp.concatenate(outs, axis=2)
    o = o.transpose(0, 2, 1, 3).reshape(B, S, D).astype(h.dtype)
    return o @ w_out


def rotary(x, pos):
    half = x.shape[-1] // 2
    inv_freq = ROPE_BASE ** (-jnp.arange(half, dtype=jnp.float32) / half)
    ang = pos[:, None] * inv_freq[None, :]
    cos, sin = jnp.cos(ang), jnp.sin(ang)
    x1, x2 = x[..., :half], x[..., half:]
    return jnp.concatenate([x1 * cos - x2 * sin, x1 * sin + x2 * cos], axis=-1)


def retention(h, w_in, gn_gain, w_out):
    B, S, D = h.shape
    H, dk, dv = RET_HEADS, RET_QK_DIM, RET_V_DIM
    q, k, v, g = jnp.split(h @ w_in, [D, 2 * D, 4 * D], axis=-1)
    def heads(a, d):
        return a.reshape(B, S, H, d).transpose(0, 2, 1, 3).astype(jnp.float32)
    pos = jnp.arange(S, dtype=jnp.float32)
    q = rotary(heads(q, dk), pos)
    k = rotary(heads(k, dk), pos) * (dk ** -0.5)
    v = heads(v, dv)
    log_gamma = jnp.log1p(-jnp.exp2(-5.0 - jnp.arange(H, dtype=jnp.float32)))
    n = jnp.arange(CHUNK, dtype=jnp.float32)
    diff = n[:, None] - n[None, :]
    intra_decay = jnp.where(diff >= 0, jnp.exp(jnp.maximum(diff, 0.0) * log_gamma[:, None, None]), 0.0)
    query_decay = jnp.exp((n + 1.0)[None, :] * log_gamma[:, None])[..., None]
    key_decay = jnp.exp((CHUNK - 1.0 - n)[None, :] * log_gamma[:, None])[..., None]
    chunk_decay = jnp.exp(CHUNK * log_gamma)[:, None, None]
    n_chunks = S // CHUNK
    def to_chunks(a):
        return a.reshape(B, H, n_chunks, CHUNK, a.shape[-1]).transpose(2, 0, 1, 3, 4)
    def step(state, xs):
        qc, kc, vc = xs
        scores = jnp.einsum('bhcd,bhmd->bhcm', qc, kc) * intra_decay
        inner = jnp.einsum('bhcm,bhme->bhce', scores, vc)
        cross = jnp.einsum('bhcd,bhde->bhce', qc, state) * query_decay
        state = state * chunk_decay + jnp.einsum('bhmd,bhme->bhde', kc * key_decay, vc)
        return state, inner + cross
    state0 = jnp.zeros((B, H, dk, dv), jnp.float32)
    _, o = lax.scan(step, state0, (to_chunks(q), to_chunks(k), to_chunks(v)))
    o = o.transpose(1, 3, 0, 2, 4).reshape(B, S, H, dv)
    mu = jnp.mean(o, axis=-1, keepdims=True)
    var = jnp.mean(jnp.square(o - mu), axis=-1, keepdims=True)
    o = ((o - mu) * lax.rsqrt(var + GN_EPS)).reshape(B, S, H * dv) * gn_gain.astype(jnp.float32)
    y = jax.nn.silu(g.astype(jnp.float32)) * o
    return y.astype(h.dtype) @ w_out


def memory_cross_attention(h, mem_n, w_q, w_kv, w_o):
    B, S, D = h.shape
    q = (h @ w_q).reshape(B, S, XA_HEADS, XA_HEAD_DIM)
    k, v = jnp.split(mem_n @ w_kv, 2, axis=-1)
    k = k.reshape(B, -1, XA_HEADS, XA_HEAD_DIM)
    v = v.reshape(B, -1, XA_HEADS, XA_HEAD_DIM)
    s = jnp.einsum('bshd,bmhd->bhsm', q, k).astype(jnp.float32) * (XA_HEAD_DIM ** -0.5)
    p = jax.nn.softmax(s, axis=-1).astype(h.dtype)
    o = jnp.einsum('bhsm,bmhd->bshd', p, v).reshape(B, S, D)
    return o @ w_o


def swiglu(h, w_in, w_out):
    gate, up = jnp.split(h @ w_in, 2, axis=-1)
    return (jax.nn.silu(gate) * up) @ w_out


def setup_inputs(seed: int = 0) -> dict:
    key = jax.random.key(seed)
    ks = jax.random.split(key, 24)
    f32 = jnp.float32
    def dense(k, shape, fan_in):
        return jax.random.normal(k, shape, f32) * (fan_in ** -0.5)
    def gain(k, shape):
        return 1.0 + 0.1 * jax.random.normal(k, shape, f32)
    D = D_MODEL
    return {
        "x": jax.random.normal(ks[0], (BATCH, SEQ, D), f32),
        "mem": jax.random.normal(ks[1], (BATCH, MEM_LEN, D), f32),
        "norm_mix_pre": gain(ks[2], (DEPTH, D)),
        "norm_mix_post": gain(ks[3], (DEPTH, D)),
        "norm_xa_pre": gain(ks[4], (DEPTH, D)),
        "norm_xa_post": gain(ks[5], (DEPTH, D)),
        "norm_mem": gain(ks[6], (DEPTH, D)),
        "norm_ffn_pre": gain(ks[7], (DEPTH, D)),
        "norm_ffn_post": gain(ks[8], (DEPTH, D)),
        "pool_w": dense(ks[9], (N_POOL_LAYERS, POOL_GROUPS, POOL_GROUP_DIM, POOL_GROUP_DIM), POOL_GROUP_DIM),
        "pool_scale": gain(ks[10], (N_POOL_LAYERS, D)),
        "sb_w_in": dense(ks[11], (N_SB_LAYERS, D, 3 * D), D),
        "sb_w_out": dense(ks[12], (N_SB_LAYERS, D, D), D),
        "ret_w_in": dense(ks[13], (N_RET_LAYERS, D, 6 * D), D),
        "ret_gn": gain(ks[14], (N_RET_LAYERS, 2 * D)),
        "ret_w_out": dense(ks[15], (N_RET_LAYERS, 2 * D, D), 2 * D),
        "xa_w_q": dense(ks[16], (DEPTH, D, D), D),
        "xa_w_kv": dense(ks[17], (DEPTH, D, 2 * D), D),
        "xa_w_o": dense(ks[18], (DEPTH, D, D), D),
        "ffn_w_in": dense(ks[19], (DEPTH, D, 2 * D_FF), D),
        "ffn_w_out": dense(ks[20], (DEPTH, D_FF, D), D_FF),
    }


def reference(x, mem, norm_mix_pre, norm_mix_post, norm_xa_pre, norm_xa_post, norm_mem,
              norm_ffn_pre, norm_ffn_post, pool_w, pool_scale, sb_w_in, sb_w_out,
              ret_w_in, ret_gn, ret_w_out, xa_w_q, xa_w_kv, xa_w_o, ffn_w_in, ffn_w_out):
    for i in range(DEPTH):
        kind = i % N_MIXERS
        j = i // N_MIXERS
        hn = rms_norm(x, norm_mix_pre[i])
        if kind == 0:
            m = pool_mixer(hn, pool_w[j], pool_scale[j])
        elif kind == 1:
            m = stick_breaking_attention(hn, sb_w_in[j], sb_w_out[j])
        else:
            m = retention(hn, ret_w_in[j], ret_gn[j], ret_w_out[j])
        x = x + rms_norm(m, norm_mix_post[i])
        mem_n = rms_norm(mem, norm_mem[i])
        c = memory_cross_attention(rms_norm(x, norm_xa_pre[i]), mem_n, xa_w_q[i], xa_w_kv[i], xa_w_o[i])
        x = x + rms_norm(c, norm_xa_post[i])
        f = swiglu(rms_norm(x, norm_ffn_pre[i]), ffn_w_in[i], ffn_w_out[i])
        x = x + rms_norm(f, norm_ffn_post[i])
    return x
```

```cpp
#include <hip/hip_runtime.h>
#include <cstdio>
#include <cstdint>

#define LAS __attribute__((address_space(3)))
#define GAS __attribute__((address_space(1)))
typedef unsigned short bf16_t;
typedef short bf16x8 __attribute__((ext_vector_type(8)));
typedef short bf16x4 __attribute__((ext_vector_type(4)));
typedef float f32x4 __attribute__((ext_vector_type(4)));
typedef float f32x2 __attribute__((ext_vector_type(2)));
typedef float f32x16 __attribute__((ext_vector_type(16)));
typedef unsigned u32x4 __attribute__((ext_vector_type(4)));
typedef unsigned u32x2 __attribute__((ext_vector_type(2)));
typedef __bf16 bf16x2_t __attribute__((ext_vector_type(2)));
#define DI __device__ __forceinline__

constexpr int NB = 16, SEQ = 4096, DM = 1024, NTOK = NB * SEQ, DEPTH = 4, DFF = 2816, MEML = 256, NMEM = NB * MEML;
constexpr int LDT = 4160;
constexpr int LDR = 4104;
constexpr float RMS_EPS = 1e-6f, GN_EPS = 1e-5f, LOG2E = 1.4426950408889634f;

constexpr size_t MiB = 1u << 20;
constexpr size_t WS_CTL = 0, CTL_ZERO_BYTES = 64 * 1024;
constexpr size_t WS_RSTD = 1 * MiB;
constexpr size_t WS_MRSTD = WS_RSTD + 256 * 1024;
constexpr size_t WS_ROPE = 2 * MiB;
constexpr size_t WS_MEMB = 10 * MiB;
constexpr size_t WS_KMEM = 18 * MiB;
constexpr size_t WS_VTMEM = 50 * MiB;
constexpr size_t WS_WB = 82 * MiB;
constexpr size_t WS_XB = 210 * MiB;
constexpr size_t WS_MB = 338 * MiB;
constexpr size_t WS_R = 466 * MiB;
constexpr size_t WS_XCH = WS_R + 520 * MiB;
constexpr size_t WS_SSQ = WS_XCH + 2 * MiB;
constexpr size_t WS_SC = WS_SSQ + 1 * MiB;
constexpr size_t WS_END = WS_SC + 32 * MiB;

constexpr size_t WO_POOL = 0;
constexpr size_t WO_SB_QK = WO_POOL + 2 * 262144;
constexpr size_t WO_SB_V = WO_SB_QK + 2048 * 1024;
constexpr size_t WO_SB_O = WO_SB_V + 1024 * 1024;
constexpr size_t WO_RT_QK = WO_SB_O + 1024 * 1024;
constexpr size_t WO_RT_KV = WO_RT_QK + 2048 * 1024;
constexpr size_t WO_RT_G = WO_RT_KV + 3072 * 1024;
constexpr size_t WO_RT_O = WO_RT_G + 2048 * 1024;
constexpr size_t WO_XA_Q = WO_RT_O + 1024 * 2048;
constexpr size_t WO_XA_K = WO_XA_Q + 4 * 1024 * 1024;
constexpr size_t WO_XA_V = WO_XA_K + 4 * 1024 * 1024;
constexpr size_t WO_XA_O = WO_XA_V + 4 * 1024 * 1024;
constexpr size_t WO_FF_IN = WO_XA_O + 4 * 1024 * 1024;
constexpr size_t WO_FF_OUT = WO_FF_IN + 4 * (size_t)5632 * 1024;
constexpr size_t WO_END = WO_FF_OUT + 4 * (size_t)1024 * 2816;
static_assert(WO_END * 2 <= 128 * MiB, "weights fit");

constexpr int CW_BAR = 4096;
constexpr int CW_GRP = 8192;

constexpr int RING_BYTES = 131072;
constexpr int SMX_OFF = RING_BYTES;
constexpr int MISC_OFF = RING_BYTES + 16384;
constexpr int RT_OFF = 149504;
constexpr int LDS_BYTES = 157696;

DI unsigned cvtpk(float lo, float hi) { f32x2 v = {lo, hi}; bf16x2_t b = __builtin_convertvector(v, bf16x2_t); return __builtin_bit_cast(unsigned, b); }
DI float bf2f(unsigned short b) { return __uint_as_float(((unsigned)b) << 16); }
DI float bflo(unsigned w) { return __uint_as_float(w << 16); }
DI float bfhi(unsigned w) { return __uint_as_float(w & 0xffff0000u); }
DI float xsum16(float v) { const auto r = __builtin_amdgcn_permlane16_swap(__float_as_uint(v), __float_as_uint(v), false, false); return __uint_as_float(r[0]) + __uint_as_float(r[1]); }
DI float xsum32(float v) { const auto r = __builtin_amdgcn_permlane32_swap(__float_as_uint(v), __float_as_uint(v), false, false); return __uint_as_float(r[0]) + __uint_as_float(r[1]); }
DI float xmax16(float v) { const auto r = __builtin_amdgcn_permlane16_swap(__float_as_uint(v), __float_as_uint(v), false, false); return fmaxf(__uint_as_float(r[0]), __uint_as_float(r[1])); }
DI float xmax32(float v) { const auto r = __builtin_amdgcn_permlane32_swap(__float_as_uint(v), __float_as_uint(v), false, false); return fmaxf(__uint_as_float(r[0]), __uint_as_float(r[1])); }
DI float xchg32(float v, int upper) { const auto r = __builtin_amdgcn_permlane32_swap(__float_as_uint(v), __float_as_uint(v), false, false); return __uint_as_float(upper ? r[0] : r[1]); }
DI float rowsum16(float v) {
    v += __uint_as_float(__builtin_amdgcn_update_dpp(0, __float_as_uint(v), 0x128, 0xf, 0xf, false));
    v += __uint_as_float(__builtin_amdgcn_update_dpp(0, __float_as_uint(v), 0x124, 0xf, 0xf, false));
    v += __uint_as_float(__builtin_amdgcn_update_dpp(0, __float_as_uint(v), 0x122, 0xf, 0xf, false));
    v += __uint_as_float(__builtin_amdgcn_update_dpp(0, __float_as_uint(v), 0x121, 0xf, 0xf, false));
    return v; }
DI float wave_sum(float v) { return xsum32(xsum16(rowsum16(v))); }
DI float ex2(float x) { return __builtin_amdgcn_exp2f(x); }
DI float lg2(float x) { return __builtin_amdgcn_logf(x); }
DI float rstd_of(const float* ssq, int row) { const f32x4 p = *(const f32x4*)(ssq + (size_t)row * 4); return __builtin_amdgcn_rsqf(((p[0] + p[1]) + (p[2] + p[3])) * (1.0f / DM) + RMS_EPS); }
DI float rstd_q(const f32x4 p) { return __builtin_amdgcn_rsqf(((p[0] + p[1]) + (p[2] + p[3])) * (1.0f / DM) + RMS_EPS); }
DI float silu(float g) { return g * __builtin_amdgcn_rcpf(1.0f + ex2(-g * LOG2E)); }
#define LDS_WAIT() asm volatile("s_waitcnt lgkmcnt(0)" ::: "memory")
#define VM_WAIT() asm volatile("s_waitcnt vmcnt(0)" ::: "memory")

namespace pg8 {
constexpr int BM = 256, BK = 64, HALF = 128, HTB = HALF * BK * 2, STAGE_BYTES = 8 * HTB, NXCD = 8, WGM = 8;
DI int lds_byte(int r, int c) { const int st = (r >> 4) * 2 + (c >> 5), rr = r & 15, cc = c & 31, ob = rr * 64 + cc * 2; return st * 1024 + (ob ^ (((ob >> 9) & 1) << 5)); }
DI void stage_rc(int b, int& R, int& C) { const int st = b / 1024, sb = b % 1024, swz = sb ^ (((sb >> 9) & 1) << 5); R = (st >> 1) * 16 + swz / 64; C = (st & 1) * 32 + (swz % 64) / 2; }
DI int perm32(int rho) { const int n = rho >> 4, i = rho & 15; return 8 * (i >> 2) + 4 * n + (i & 3); }
struct Unit { int pm, pn; };
struct Gemm { const bf16_t* A; const bf16_t* B; int lda, ldb, K, nM, nN, msh, nsh; long a_ml, a_mh, a_nl, a_nh, b_ml, b_mh, b_nl, b_nh;
    DI const char* aptr(int pm, int pn) const { return (const char*)(A + (size_t)(pm & ((1 << msh) - 1)) * a_ml + (size_t)(pm >> msh) * a_mh + (size_t)(pn & ((1 << nsh) - 1)) * a_nl + (size_t)(pn >> nsh) * a_nh); }
    DI const char* bptr(int pm, int pn) const { return (const char*)(B + (size_t)(pm & ((1 << msh) - 1)) * b_ml + (size_t)(pm >> msh) * b_mh + (size_t)(pn & ((1 << nsh) - 1)) * b_nl + (size_t)(pn >> nsh) * b_nh); } };
DI Gemm mk_gemm(const bf16_t* A, const bf16_t* B, int lda, int ldb, int K, int nM, int nN, long a_pn, long b_pn, long b_z, int zshift) {
    return Gemm{A, B, lda, ldb, K, nM, nN, zshift, 30, 256L * lda, (256L * lda) << zshift, a_pn, 0, 0, b_z, b_pn, 0}; }
struct StaticOrder {
    int nM, nN, nwg, G, c;
    DI void init(int nM_, int nN_, int G_, int c_) { nM = nM_; nN = nN_; nwg = nM * nN; G = G_; c = c_; }
    DI bool next(int i, Unit& u) const {
        const long L = (long)i * G + c; if (L >= nwg) return false;
        int wgid = (int)L; { const int q = nwg / NXCD, r = nwg % NXCD, xcd = wgid % NXCD, off = wgid / NXCD; wgid = (xcd < r ? xcd * (q + 1) : r * (q + 1) + (xcd - r) * q) + off; }
        const int nig = WGM * nN, gid = wgid / nig, fm = gid * WGM, gsz = (nM - fm) < WGM ? (nM - fm) : WGM;
        u.pm = fm + ((wgid % nig) % gsz); u.pn = (wgid % nig) / gsz; return true;
    }
};

template <class Epi, class Sched>
DI void gemm_phase(LAS unsigned char* lds, const Gemm g, const Sched& S, const Epi& E) {
    int tid = threadIdx.x; asm volatile("" : "+v"(tid));
    const int wid = __builtin_amdgcn_readfirstlane(tid >> 6), lane = tid & 63, wr = wid >> 2, wc = wid & 3, fr = lane & 15, fq = lane >> 4;
    const int K = g.K, nt = K / BK;
    unsigned voffA[2], voffB[2];
#pragma unroll
    for (int i = 0; i < 2; ++i) { int R, C; stage_rc(tid * 16 + i * 8192, R, C); const int Rb = (R & ~31) + perm32(R & 31);
        voffA[i] = (unsigned)(R * g.lda + C) * 2u; voffB[i] = (unsigned)(Rb * g.ldb + C) * 2u; }
    const size_t kstep = (size_t)(BK * 2);
    const size_t hstepA = (size_t)HALF * g.lda * 2, hstepB = (size_t)HALF * g.ldb * 2;
    const unsigned ldsw = (unsigned)wid * 1024u;
    const int aoff = lds_byte(wr * 64 + fr, fq * 8), boff = lds_byte(wc * 32 + fr, fq * 8);
#define PG8_SA(b, h) (((b) * 2 + (h)) * HTB)
#define PG8_SB(b, h) ((4 + (b) * 2 + (h)) * HTB)
#define PG8_STAGE(bufoff, gbase, voff) do { _Pragma("unroll") for (int _i = 0; _i < 2; ++_i) \
        __builtin_amdgcn_global_load_lds((const unsigned*)((const char*)(gbase) + (voff)[_i]), (LAS unsigned*)(lds + (bufoff) + ldsw + _i * 8192), 16, 0, 0); } while (0)
#define PG8_LDA(dst, b, h) do { _Pragma("unroll") for (int m = 0; m < 4; ++m) _Pragma("unroll") for (int k = 0; k < 2; ++k) dst[m][k] = *(const LAS bf16x8*)(lds + PG8_SA(b, h) + aoff + m * 2048 + k * 1024); } while (0)
#define PG8_LDB(dst, b, h) do { _Pragma("unroll") for (int n = 0; n < 2; ++n) _Pragma("unroll") for (int k = 0; k < 2; ++k) dst[n][k] = *(const LAS bf16x8*)(lds + PG8_SB(b, h) + boff + n * 2048 + k * 1024); } while (0)
#define PG8_MMA(ai, bj, At, Bt) do { __builtin_amdgcn_s_setprio(1); _Pragma("unroll") for (int m = 0; m < 4; ++m) _Pragma("unroll") for (int n = 0; n < 2; ++n) _Pragma("unroll") for (int k = 0; k < 2; ++k) \
        acc[ai][bj][m][n] = __builtin_amdgcn_mfma_f32_16x16x32_bf16(Bt[n][k], At[m][k], acc[ai][bj][m][n], 0, 0, 0); __builtin_amdgcn_s_setprio(0); } while (0)
#define PG8_WAIT_V(n) asm volatile("s_waitcnt vmcnt(" #n ")" ::: "memory")
#define PG8_WAIT_L(n) asm volatile("s_waitcnt lgkmcnt(" #n ")" ::: "memory")
#define PG8_BAR __builtin_amdgcn_s_barrier()
#define PG8_SCHED __builtin_amdgcn_sched_barrier(0)
    Unit cur, nxt; int ui = 0;
    if (!S.next(0, cur)) return;
    f32x4 acc[2][2][4][2];
#pragma unroll
    for (int a = 0; a < 2; ++a)
#pragma unroll
        for (int b = 0; b < 2; ++b)
#pragma unroll
            for (int m = 0; m < 4; ++m)
#pragma unroll
                for (int n = 0; n < 2; ++n) acc[a][b][m][n] = (f32x4){0.f, 0.f, 0.f, 0.f};
    bf16x8 At[4][2], B0[2][2], B1[2][2];
    const char* cA = g.aptr(cur.pm, cur.pn);
    const char* cB = g.bptr(cur.pm, cur.pn);
    LAS float* rtab = (LAS float*)(lds + RT_OFF);
    const float* rsp = nullptr;
    if constexpr (Epi::ROWSTAT) { rsp = E.rs ? E.rs : (const float*)g.A;
        __builtin_amdgcn_global_load_lds((const unsigned*)(rsp + (size_t)(cur.pm * BM + (wid & 3) * 64 + lane) * 4), (LAS unsigned*)(rtab + (wid & 3) * 256), 16, 0, 0); }
    PG8_STAGE(PG8_SB(0, 0), cB, voffB); PG8_STAGE(PG8_SB(0, 1), cB + hstepB, voffB); PG8_STAGE(PG8_SA(0, 0), cA, voffA); PG8_STAGE(PG8_SA(0, 1), cA + hstepA, voffA);
    if (wr == 1) PG8_BAR;
    PG8_WAIT_V(2); PG8_BAR;
    PG8_STAGE(PG8_SB(1, 0), cB + kstep, voffB); PG8_STAGE(PG8_SA(1, 0), cA + kstep, voffA); PG8_STAGE(PG8_SB(1, 1), cB + hstepB + kstep, voffB);
    PG8_WAIT_V(6); PG8_BAR;
    for (;;) {
        const bool has_next = S.next(ui + 1, nxt);
        const char* nA = has_next ? g.aptr(nxt.pm, nxt.pn) : cA;
        const char* nB = has_next ? g.bptr(nxt.pm, nxt.pn) : cB;
        for (int t = 0; t < nt; t += 2) {
            const bool last = (t == nt - 2);
            const char* a1 = cA + (size_t)(t + 1) * kstep;
            const char* a2 = last ? nA : cA + (size_t)(t + 2) * kstep; const char* b2 = last ? nB : cB + (size_t)(t + 2) * kstep;
            const char* a3 = a2 + kstep; const char* b3 = b2 + kstep;
            PG8_LDB(B0, 0, 0); PG8_LDB(B1, 0, 1); PG8_SCHED; PG8_LDA(At, 0, 0); PG8_STAGE(PG8_SA(1, 1), a1 + hstepA, voffA);
            PG8_WAIT_V(8); PG8_WAIT_L(0); PG8_BAR; PG8_MMA(0, 0, At, B0); PG8_MMA(0, 1, At, B1); PG8_BAR; PG8_SCHED;
            PG8_LDA(At, 0, 1); PG8_STAGE(PG8_SB(0, 0), b2, voffB); PG8_STAGE(PG8_SB(0, 1), b2 + hstepB, voffB); PG8_STAGE(PG8_SA(0, 0), a2, voffA);
            PG8_WAIT_V(8); PG8_WAIT_L(0); PG8_BAR; PG8_MMA(1, 0, At, B0); PG8_MMA(1, 1, At, B1); PG8_BAR; PG8_SCHED;
            PG8_LDB(B0, 1, 0); PG8_LDB(B1, 1, 1); PG8_SCHED; PG8_LDA(At, 1, 0); PG8_STAGE(PG8_SA(0, 1), a2 + hstepA, voffA);
            PG8_WAIT_V(8); PG8_WAIT_L(0); PG8_BAR; PG8_MMA(0, 0, At, B0); PG8_MMA(0, 1, At, B1); PG8_BAR; PG8_SCHED;
            PG8_LDA(At, 1, 1); PG8_STAGE(PG8_SB(1, 0), b3, voffB); PG8_STAGE(PG8_SB(1, 1), b3 + hstepB, voffB); PG8_STAGE(PG8_SA(1, 0), a3, voffA);
            PG8_WAIT_V(8); PG8_WAIT_L(0); PG8_BAR; PG8_MMA(1, 0, At, B0); PG8_MMA(1, 1, At, B1); PG8_BAR; PG8_SCHED;
        }
        if (wr == 0) PG8_BAR;
        if constexpr (!Epi::AFTER_DRAIN) { int fr_ = fr, fq_ = fq; asm volatile("" : "+v"(fr_), "+v"(fq_));
          if constexpr (Epi::ROWSTAT) __builtin_amdgcn_global_load_lds((const unsigned*)(rsp + (size_t)((has_next ? nxt.pm : cur.pm) * BM + (wid & 3) * 64 + lane) * 4), (LAS unsigned*)(rtab + ((ui + 1) & 1) * 1024 + (wid & 3) * 256), 16, 0, 0);
          E(acc, cur, wr, wc, fr_, fq_, rtab + (ui & 1) * 1024); }
        if (!has_next) break;
#pragma unroll
        for (int a = 0; a < 2; ++a)
#pragma unroll
            for (int b = 0; b < 2; ++b)
#pragma unroll
                for (int m = 0; m < 4; ++m)
#pragma unroll
                    for (int n = 0; n < 2; ++n) acc[a][b][m][n] = (f32x4){0.f, 0.f, 0.f, 0.f};
        cur = nxt; cA = nA; cB = nB; ++ui;
        if (wr == 1) PG8_BAR;
    }
    PG8_WAIT_V(0);
    PG8_BAR;
    if constexpr (Epi::AFTER_DRAIN) { int fr_ = fr, fq_ = fq; asm volatile("" : "+v"(fr_), "+v"(fq_)); E.fused(acc, cur, wr, wc, fr_, fq_, lds, wid, lane); }
#undef PG8_SA
#undef PG8_SB
#undef PG8_STAGE
#undef PG8_LDA
#undef PG8_LDB
#undef PG8_MMA
#undef PG8_WAIT_V
#undef PG8_WAIT_L
#undef PG8_BAR
#undef PG8_SCHED
}

struct RoundOrder : StaticOrder { int round; DI bool next(int i, Unit& u) const { return i == 0 ? StaticOrder::next(round, u) : false; } };
struct GroupOrder {
    int grp, w, TT, PB, TB, ntb, rounds; bool tokM; int tail0 = 1 << 30;
    DI void init(bool tokM_, int TT_, int nOther, int PB_, int TB_, int grp_, int w_) { tokM = tokM_; TT = TT_; PB = PB_; TB = TB_; ntb = nOther / TB_; rounds = TT_ * nOther / 16; grp = grp_; w = w_; }
    DI bool next(int i, Unit& u) const {
        if (i >= rounds) return false;
        if (i >= tail0) { const int bt8 = TT * grp + (i - tail0) * 8 + (w & 7), ot2 = ntb * TB + (w >> 3); if (tokM) { u.pm = bt8; u.pn = ot2; } else { u.pm = ot2; u.pn = bt8; } return true; }
        const int pb = i / ntb, tb = i - pb * ntb, bt = TT * grp + pb * PB + (w % PB), ot = tb * TB + (w / PB);
        if (tokM) { u.pm = bt; u.pn = ot; } else { u.pm = ot; u.pn = bt; }
        return true; }
};
typedef f32x4 Acc[2][2][4][2];

struct EpiStore {
    static constexpr bool AFTER_DRAIN = false; static constexpr bool ROWSTAT = true;
    bf16_t* O; long ldc; const float* rs; const float* cs; int csh; long cbs;
    DI void operator()(const Acc& acc, const Unit& u, int wr, int wc, int fr, int fq, const LAS float* rt) const {
        const int row0 = u.pm * BM + wr * 64 + fr;
        const long cbase = (long)(u.pn >> csh) * cbs + (long)(u.pn & ((1 << csh) - 1)) * 256 + wc * 32 + 8 * fq;
        float pr[2][4];
        if (rs) {
#pragma unroll
            for (int ai = 0; ai < 2; ++ai)
#pragma unroll
                for (int m = 0; m < 4; ++m) pr[ai][m] = rstd_q(*(const LAS f32x4*)(rt + 4 * (ai * HALF + wr * 64 + m * 16 + fr))); }
        float csv[2][8];
#pragma unroll
        for (int bj = 0; bj < 2; ++bj) {
            if (cs) {
#pragma unroll
                for (int k = 0; k < 8; ++k) csv[bj][k] = rstd_of(cs, u.pn * BM + bj * HALF + wc * 32 + 8 * fq + k); }
            else {
#pragma unroll
                for (int k = 0; k < 8; ++k) csv[bj][k] = 1.f; }
        }
        asm volatile("" ::: "memory");
#pragma unroll
        for (int ai = 0; ai < 2; ++ai)
#pragma unroll
            for (int m = 0; m < 4; ++m) { const int row = row0 + ai * HALF + m * 16; const float r = rs ? pr[ai][m] : 1.f;
                bf16_t* rowp = O + (size_t)row * ldc + cbase;
#pragma unroll
                for (int bj = 0; bj < 2; ++bj) { const f32x4 v0 = acc[ai][bj][m][0], v1 = acc[ai][bj][m][1];
                    u32x4 w; w.x = cvtpk(v0[0] * r * csv[bj][0], v0[1] * r * csv[bj][1]); w.y = cvtpk(v0[2] * r * csv[bj][2], v0[3] * r * csv[bj][3]);
                    w.z = cvtpk(v1[0] * r * csv[bj][4], v1[1] * r * csv[bj][5]); w.w = cvtpk(v1[2] * r * csv[bj][6], v1[3] * r * csv[bj][7]);
                    *(u32x4*)(rowp + bj * HALF) = w; } }
    }
};
struct EpiSwiglu {
    static constexpr bool AFTER_DRAIN = false; static constexpr bool ROWSTAT = true;
    bf16_t* O; long ldc; const float* rs;
    DI void operator()(const Acc& acc, const Unit& u, int wr, int wc, int fr, int fq, const LAS float* rt) const {
        const int row0 = u.pm * BM + wr * 64 + fr; const int col = u.pn * 128 + wc * 32 + 8 * fq;
        float pr[2][4];
#pragma unroll
        for (int ai = 0; ai < 2; ++ai)
#pragma unroll
            for (int m = 0; m < 4; ++m) pr[ai][m] = rstd_q(*(const LAS f32x4*)(rt + 4 * (ai * HALF + wr * 64 + m * 16 + fr)));
        asm volatile("" ::: "memory");
#pragma unroll
        for (int ai = 0; ai < 2; ++ai)
#pragma unroll
            for (int m = 0; m < 4; ++m) { const int row = row0 + ai * HALF + m * 16; const float r = pr[ai][m]; const float rc = r * -LOG2E, r2i = __builtin_amdgcn_rcpf(r * r);
                const f32x4 g0 = acc[ai][0][m][0], g1 = acc[ai][0][m][1], u0 = acc[ai][1][m][0], u1 = acc[ai][1][m][1];
                const f32x4 x0 = g0 * rc, x1 = g1 * rc, p0 = g0 * u0, p1 = g1 * u1;
                f32x4 e0, e1;
#pragma unroll
                for (int i = 0; i < 4; ++i) { e0[i] = ex2(x0[i]); e1[i] = ex2(x1[i]); }
                const f32x4 d0 = e0 * r2i + r2i, d1 = e1 * r2i + r2i;
                f32x4 q0, q1;
#pragma unroll
                for (int i = 0; i < 4; ++i) { q0[i] = __builtin_amdgcn_rcpf(d0[i]); q1[i] = __builtin_amdgcn_rcpf(d1[i]); }
                const f32x4 o0 = p0 * q0, o1 = p1 * q1;
                u32x4 w; w.x = cvtpk(o0[0], o0[1]); w.y = cvtpk(o0[2], o0[3]); w.z = cvtpk(o1[0], o1[1]); w.w = cvtpk(o1[2], o1[3]);
                *(u32x4*)(O + (size_t)row * ldc + col) = w; }
    }
};
struct EpiSoftmax {
    static constexpr bool AFTER_DRAIN = false; static constexpr bool ROWSTAT = true;
    bf16_t* O; long ldc; LAS float* tab; const float* rs;
    DI void operator()(Acc& acc, const Unit& u, int wr, int wc, int fr, int fq, const LAS float* rt) const {
        float mw[2][4];
        float pr[2][4];
        if (rs) {
#pragma unroll
            for (int ai = 0; ai < 2; ++ai)
#pragma unroll
                for (int m = 0; m < 4; ++m) pr[ai][m] = rstd_q(*(const LAS f32x4*)(rt + 4 * (ai * HALF + wr * 64 + m * 16 + fr))); }
        asm volatile("" ::: "memory");
#pragma unroll
        for (int ai = 0; ai < 2; ++ai)
#pragma unroll
            for (int m = 0; m < 4; ++m) {
                const float rsc = rs ? pr[ai][m] : 1.f;
                float mx = -INFINITY;
#pragma unroll
                for (int bj = 0; bj < 2; ++bj)
#pragma unroll
                    for (int n = 0; n < 2; ++n) { const f32x4 v = acc[ai][bj][m][n]; mx = fmaxf(fmaxf(mx, fmaxf(v[0], v[1])), fmaxf(v[2], v[3])); }
                mx = xmax32(xmax16(mx)) * rsc;
                const float nm = -mx;
                float s = 0.f;
#pragma unroll
                for (int bj = 0; bj < 2; ++bj)
#pragma unroll
                    for (int n = 0; n < 2; ++n)
#pragma unroll
                        for (int i = 0; i < 4; ++i) { const float p = ex2(__builtin_fmaf(acc[ai][bj][m][n][i], rsc, nm)); acc[ai][bj][m][n][i] = p; s += p; }
                s = xsum32(xsum16(s));
                mw[ai][m] = mx;
                const int r = ai * HALF + wr * 64 + m * 16 + fr;
                if (fq == 0) { tab[(r * 4 + wc) * 2] = mx; tab[(r * 4 + wc) * 2 + 1] = s; }
            }
        LDS_WAIT(); __builtin_amdgcn_s_barrier(); asm volatile("" ::: "memory");
        const int row0 = u.pm * BM + wr * 64 + fr; const int col = u.pn * BM + wc * 32 + 8 * fq;
#pragma unroll
        for (int ai = 0; ai < 2; ++ai)
#pragma unroll
            for (int m = 0; m < 4; ++m) {
                const int r = ai * HALF + wr * 64 + m * 16 + fr;
                const f32x4 t0 = *(const LAS f32x4*)(tab + r * 8), t1 = *(const LAS f32x4*)(tab + r * 8 + 4);
                const float M = fmaxf(fmaxf(t0[0], t0[2]), fmaxf(t1[0], t1[2]));
                const float L = t0[1] * ex2(t0[0] - M) + t0[3] * ex2(t0[2] - M) + t1[1] * ex2(t1[0] - M) + t1[3] * ex2(t1[2] - M);
                const float f = ex2(mw[ai][m] - M) * __builtin_amdgcn_rcpf(L);
                bf16_t* rowp = O + (size_t)(row0 + ai * HALF + m * 16) * ldc + col;
#pragma unroll
                for (int bj = 0; bj < 2; ++bj) { const f32x4 v0 = acc[ai][bj][m][0] * f, v1 = acc[ai][bj][m][1] * f;
                    u32x4 w; w.x = cvtpk(v0[0], v0[1]); w.y = cvtpk(v0[2], v0[3]); w.z = cvtpk(v1[0], v1[1]); w.w = cvtpk(v1[2], v1[3]);
                    *(u32x4*)(rowp + bj * HALF) = w; }
            }
    }
};
struct EpiRetQK {
    static constexpr bool AFTER_DRAIN = false; static constexpr bool ROWSTAT = true;
    bf16_t* O; long ldc; const float* rs; const float* cosN; const float* sinN;
    DI void operator()(const Acc& acc, const Unit& u, int wr, int wc, int fr, int fq, const LAS float* rt) const {
        const int row0 = u.pm * BM + wr * 64 + fr; const int d0 = wc * 32 + 8 * fq, dt0 = wc * 32 + 4 * fq;
        const float lg = lg2(1.0f - ex2(-5.0f - (float)(u.pn & 3))) * (u.pn < 4 ? 1.f : -1.f);
        float pq[2]; f32x4 cc[2][2], ss[2][2];
#define RQK_LOAD(slot, ai_, m_) do { const int row_ = row0 + (ai_) * HALF + (m_) * 16; const int t_ = row_ & (SEQ - 1); pq[slot] = rstd_q(*(const LAS f32x4*)(rt + 4 * ((ai_) * HALF + wr * 64 + (m_) * 16 + fr))); \
            cc[slot][0] = *(const f32x4*)(cosN + (size_t)t_ * 128 + dt0); cc[slot][1] = *(const f32x4*)(cosN + (size_t)t_ * 128 + dt0 + 16); \
            ss[slot][0] = *(const f32x4*)(sinN + (size_t)t_ * 128 + dt0); ss[slot][1] = *(const f32x4*)(sinN + (size_t)t_ * 128 + dt0 + 16); } while (0)
        RQK_LOAD(0, 0, 0);
#pragma unroll
        for (int ai = 0; ai < 2; ++ai)
#pragma unroll
            for (int m = 0; m < 4; ++m) { const int g = ai * 4 + m, sl = g & 1; const int row = row0 + ai * HALF + m * 16; const int t = row & (SEQ - 1);
                if (g < 7) RQK_LOAD(sl ^ 1, (g + 1) >> 2, (g + 1) & 3);
                asm volatile("" ::: "memory");
                const float r = pq[sl] * ex2((float)(t & 63) * lg);
                bf16_t* rowp = O + (size_t)row * ldc + u.pn * BM + d0;
                float o1[8], o2[8];
#pragma unroll
                for (int n = 0; n < 2; ++n) { const f32x4 c = cc[sl][n], sn = ss[sl][n];
#pragma unroll
                    for (int i = 0; i < 4; ++i) { const float x1 = acc[ai][0][m][n][i] * r, x2 = acc[ai][1][m][n][i] * r; o1[4 * n + i] = x1 * c[i] - x2 * sn[i]; o2[4 * n + i] = x1 * sn[i] + x2 * c[i]; } }
                const bool hsw = (u.pn >= 4) && ((t & 8) != 0);
                u32x4 w; w.x = cvtpk(o1[0], o1[1]); w.y = cvtpk(o1[2], o1[3]); w.z = cvtpk(o1[4], o1[5]); w.w = cvtpk(o1[6], o1[7]); if (hsw) w = (u32x4){w.z, w.w, w.x, w.y}; *(u32x4*)(rowp) = w;
                w.x = cvtpk(o2[0], o2[1]); w.y = cvtpk(o2[2], o2[3]); w.z = cvtpk(o2[4], o2[5]); w.w = cvtpk(o2[6], o2[7]); if (hsw) w = (u32x4){w.z, w.w, w.x, w.y}; *(u32x4*)(rowp + HALF) = w;
                asm volatile("" ::: "memory"); }
#undef RQK_LOAD
    }
};
struct EpiRetKVT {
    static constexpr bool AFTER_DRAIN = false; static constexpr bool ROWSTAT = false;
    bf16_t* O; const float* cs;
    DI void operator()(const Acc& acc, const Unit& u, int wr, int wc, int fr, int fq, const LAS float* rt) const {
        const int rl0 = wr * 64 + fr;
        const int tcol = (u.pn & 15) * 256 + wc * 32 + 8 * fq;
        bf16_t* base = O + (size_t)(u.pn >> 4) * 2048 * LDR + (size_t)(u.pm * BM) * LDR + tcol;
        float csv[2][8];
#pragma unroll
        for (int bj = 0; bj < 2; ++bj)
#pragma unroll
            for (int k = 0; k < 8; ++k) csv[bj][k] = rstd_of(cs, u.pn * BM + bj * HALF + wc * 32 + 8 * fq + k);
#pragma unroll
        for (int ai = 0; ai < 2; ++ai)
#pragma unroll
            for (int m = 0; m < 4; ++m) { bf16_t* rowp = base + (size_t)(rl0 + ai * HALF + m * 16) * LDR;
#pragma unroll
                for (int bj = 0; bj < 2; ++bj) { const f32x4 v0 = acc[ai][bj][m][0], v1 = acc[ai][bj][m][1];
                    u32x4 w; w.x = cvtpk(v0[0] * csv[bj][0], v0[1] * csv[bj][1]); w.y = cvtpk(v0[2] * csv[bj][2], v0[3] * csv[bj][3]);
                    w.z = cvtpk(v1[0] * csv[bj][4], v1[1] * csv[bj][5]); w.w = cvtpk(v1[2] * csv[bj][6], v1[3] * csv[bj][7]);
                    *(u32x4*)(rowp + bj * HALF) = w; } }
    }
};
struct EpiRetGate {
    static constexpr bool AFTER_DRAIN = false; static constexpr bool ROWSTAT = true;
    bf16_t* Y; long ldc; const float* rs; const float* gns; const float* gain;
    DI void operator()(const Acc& acc, const Unit& u, int wr, int wc, int fr, int fq, const LAS float* rt) const {
        const int row0 = u.pm * BM + wr * 64 + fr; const int col = u.pn * BM + wc * 32 + 8 * fq;
        float gv[2][8];
#pragma unroll
        for (int bj = 0; bj < 2; ++bj) { const f32x4 a = *(const f32x4*)(gain + col + bj * HALF), b = *(const f32x4*)(gain + col + bj * HALF + 4);
            gv[bj][0] = a[0]; gv[bj][1] = a[1]; gv[bj][2] = a[2]; gv[bj][3] = a[3]; gv[bj][4] = b[0]; gv[bj][5] = b[1]; gv[bj][6] = b[2]; gv[bj][7] = b[3]; }
        float pq[2]; f32x4 g0[2], g1[2]; u32x4 on[2][2];
#define RG_LOAD(slot, ai_, m_) do { const int row_ = row0 + (ai_) * HALF + (m_) * 16; pq[slot] = rstd_q(*(const LAS f32x4*)(rt + 4 * ((ai_) * HALF + wr * 64 + (m_) * 16 + fr))); \
            g0[slot] = *(const f32x4*)(gns + (size_t)row_ * 32 + (u.pn >> 1) * 8); g1[slot] = *(const f32x4*)(gns + (size_t)row_ * 32 + (u.pn >> 1) * 8 + 4); \
            on[slot][0] = *(const u32x4*)(Y + (size_t)row_ * ldc + col); on[slot][1] = *(const u32x4*)(Y + (size_t)row_ * ldc + col + HALF); } while (0)
        RG_LOAD(0, 0, 0);
#pragma unroll
        for (int ai = 0; ai < 2; ++ai)
#pragma unroll
            for (int m = 0; m < 4; ++m) { const int g = ai * 4 + m, sl = g & 1; const int row = row0 + ai * HALF + m * 16;
                if (g < 7) RG_LOAD(sl ^ 1, (g + 1) >> 2, (g + 1) & 3);
                asm volatile("" ::: "memory");
                const float r = pq[sl]; const f32x4 p0 = g0[sl], p1 = g1[sl];
                const float mu = ((p0[0] + p0[2]) + (p1[0] + p1[2])) * (1.0f / 512.0f), ex2v = ((p0[1] + p0[3]) + (p1[1] + p1[3])) * (1.0f / 512.0f);
                const float gr = __builtin_amdgcn_rsqf(fmaxf(ex2v - mu * mu, 0.f) + GN_EPS);
                bf16_t* rowp = Y + (size_t)row * ldc + col;
#pragma unroll
                for (int bj = 0; bj < 2; ++bj) { const u32x4 onv = on[sl][bj]; const f32x4 v0 = acc[ai][bj][m][0], v1 = acc[ai][bj][m][1];
                    u32x4 w;
                    w.x = cvtpk(silu(v0[0] * r) * (bflo(onv.x) - mu) * gr * gv[bj][0], silu(v0[1] * r) * (bfhi(onv.x) - mu) * gr * gv[bj][1]); w.y = cvtpk(silu(v0[2] * r) * (bflo(onv.y) - mu) * gr * gv[bj][2], silu(v0[3] * r) * (bfhi(onv.y) - mu) * gr * gv[bj][3]);
                    w.z = cvtpk(silu(v1[0] * r) * (bflo(onv.z) - mu) * gr * gv[bj][4], silu(v1[1] * r) * (bfhi(onv.z) - mu) * gr * gv[bj][5]); w.w = cvtpk(silu(v1[2] * r) * (bflo(onv.w) - mu) * gr * gv[bj][6], silu(v1[3] * r) * (bfhi(onv.w) - mu) * gr * gv[bj][7]);
                    *(u32x4*)(rowp + bj * HALF) = w; }
                asm volatile("" ::: "memory"); }
#undef RG_LOAD
    }
};
struct EpiNormRes {
    static constexpr bool AFTER_DRAIN = false; static constexpr bool ROWSTAT = false;
    const bf16_t* xin; bf16_t* xout; float* out32; float* ssq; const float* gpost; unsigned long long* xch; unsigned epoch; LAS unsigned char* tab;
    DI void operator()(Acc& acc, const Unit& u, int wr, int wc, int fr, int fq, const LAS float* rt) const {
        (void)rt;
        const int wid = wr * 4 + wc, lane = fq * 16 + fr;
        LAS float* P = (LAS float*)tab; LAS float* Sg = (LAS float*)(tab + 4096); LAS float* P2 = (LAS float*)(tab + 5120);
        const int col0 = u.pn * BM + wc * 32 + 8 * fq;
        u32x4 xp0[4][2], xp1[4][2];
#pragma unroll
        for (int m = 0; m < 4; ++m)
#pragma unroll
            for (int bj = 0; bj < 2; ++bj) xp0[m][bj] = *(const u32x4*)(xin + (size_t)(u.pm * BM + wr * 64 + m * 16 + fr) * DM + col0 + bj * HALF);
        float gv[2][8];
#pragma unroll
        for (int bj = 0; bj < 2; ++bj) { const f32x4 a = *(const f32x4*)(gpost + col0 + bj * HALF), b = *(const f32x4*)(gpost + col0 + bj * HALF + 4);
            gv[bj][0] = a[0]; gv[bj][1] = a[1]; gv[bj][2] = a[2]; gv[bj][3] = a[3]; gv[bj][4] = b[0]; gv[bj][5] = b[1]; gv[bj][6] = b[2]; gv[bj][7] = b[3]; }
        u32x2 pk[2][4][2];
#pragma unroll
        for (int ai = 1; ai >= 0; --ai) {
#pragma unroll
            for (int m = 0; m < 4; ++m) { float q = 0.f;
#pragma unroll
                for (int bj = 0; bj < 2; ++bj)
#pragma unroll
                    for (int n = 0; n < 2; ++n) { const f32x4 v = acc[ai][bj][m][n]; q += (v[0] * v[0] + v[1] * v[1]) + (v[2] * v[2] + v[3] * v[3]);
                        if (ai == 1) { pk[bj][m][n].x = cvtpk(v[0], v[1]); pk[bj][m][n].y = cvtpk(v[2], v[3]); } }
                q = xsum32(xsum16(q));
                if (fq == 0) P[(ai * HALF + wr * 64 + m * 16 + fr) * 4 + wc] = q; }
            if (ai == 1) { asm volatile("" ::: "memory");
#pragma unroll
                for (int m = 0; m < 4; ++m)
#pragma unroll
                    for (int bj = 0; bj < 2; ++bj) xp1[m][bj] = *(const u32x4*)(xin + (size_t)(u.pm * BM + HALF + wr * 64 + m * 16 + fr) * DM + col0 + bj * HALF);
                asm volatile("" ::: "memory"); }
        }
        LDS_WAIT(); __builtin_amdgcn_s_barrier(); asm volatile("" ::: "memory");
        const int row = wid * 32 + (lane & 31);
        if (lane < 32) { const f32x4 p = *(const LAS f32x4*)(P + row * 4); const float t = (p[0] + p[1]) + (p[2] + p[3]);
            unsigned long long* sl = xch + (size_t)(u.pm * BM + row) * 4;
            __hip_atomic_store(sl + u.pn, ((unsigned long long)epoch << 32) | __float_as_uint(t), __ATOMIC_RELAXED, __HIP_MEMORY_SCOPE_AGENT);
            float tot = 0.f; unsigned sp = 0;
            for (;;) { bool ok = true; tot = 0.f;
#pragma unroll
                for (int k = 0; k < 4; ++k) { const unsigned long long g = __hip_atomic_load(sl + k, __ATOMIC_RELAXED, __HIP_MEMORY_SCOPE_AGENT); ok &= ((unsigned)(g >> 32) == epoch); tot += __uint_as_float((unsigned)g); }
                if (ok || ++sp > (1u << 20)) break;
                __builtin_amdgcn_s_sleep(1); }
            Sg[row] = __builtin_amdgcn_rsqf(tot * (1.0f / DM) + RMS_EPS); }
        LDS_WAIT(); __builtin_amdgcn_s_barrier(); asm volatile("" ::: "memory");
        __builtin_amdgcn_s_waitcnt(0x0F70);
#pragma unroll
        for (int ai = 0; ai < 2; ++ai)
#pragma unroll
            for (int m = 0; m < 4; ++m) { const int r = ai * HALF + wr * 64 + m * 16 + fr; const float rm = Sg[r]; const size_t off = (size_t)(u.pm * BM + r) * DM + col0; float q = 0.f;
#pragma unroll
                for (int bj = 0; bj < 2; ++bj) { const u32x4 xv = ai ? xp1[m][bj] : xp0[m][bj];
                    f32x4 v0, v1;
                    if (ai == 0) { v0 = acc[0][bj][m][0]; v1 = acc[0][bj][m][1]; }
                    else { const u32x2 a = pk[bj][m][0], b = pk[bj][m][1]; v0 = (f32x4){bflo(a.x), bfhi(a.x), bflo(a.y), bfhi(a.y)}; v1 = (f32x4){bflo(b.x), bfhi(b.x), bflo(b.y), bfhi(b.y)}; }
                    float o[8];
                    o[0] = bflo(xv.x) + v0[0] * rm * gv[bj][0]; o[1] = bfhi(xv.x) + v0[1] * rm * gv[bj][1]; o[2] = bflo(xv.y) + v0[2] * rm * gv[bj][2]; o[3] = bfhi(xv.y) + v0[3] * rm * gv[bj][3];
                    o[4] = bflo(xv.z) + v1[0] * rm * gv[bj][4]; o[5] = bfhi(xv.z) + v1[1] * rm * gv[bj][5]; o[6] = bflo(xv.w) + v1[2] * rm * gv[bj][6]; o[7] = bfhi(xv.w) + v1[3] * rm * gv[bj][7];
                    u32x4 w; w.x = cvtpk(o[0], o[1]); w.y = cvtpk(o[2], o[3]); w.z = cvtpk(o[4], o[5]); w.w = cvtpk(o[6], o[7]);
                    *(u32x4*)(xout + off + bj * HALF) = w;
                    if (out32) { *(f32x4*)(out32 + off + bj * HALF) = (f32x4){o[0], o[1], o[2], o[3]}; *(f32x4*)(out32 + off + bj * HALF + 4) = (f32x4){o[4], o[5], o[6], o[7]}; }
                    const float r0 = bflo(w.x), r1 = bfhi(w.x), r2 = bflo(w.y), r3 = bfhi(w.y), r4 = bflo(w.z), r5 = bfhi(w.z), r6 = bflo(w.w), r7 = bfhi(w.w);
                    q += ((r0 * r0 + r1 * r1) + (r2 * r2 + r3 * r3)) + ((r4 * r4 + r5 * r5) + (r6 * r6 + r7 * r7)); }
                q = xsum32(xsum16(q));
                if (fq == 0) P2[r * 4 + wc] = q;
                asm volatile("" ::: "memory"); }
        LDS_WAIT(); __builtin_amdgcn_s_barrier(); asm volatile("" ::: "memory");
        if (lane < 32) { const f32x4 p = *(const LAS f32x4*)(P2 + row * 4); ssq[(size_t)(u.pm * BM + row) * 4 + u.pn] = (p[0] + p[1]) + (p[2] + p[3]); }
    }
};
}

#define XB_TMO      128
#define XB_XCNT(j)  (256  + 64 * (j))
#define XB_XSUB(j)  (1280 + 64 * (j))
#define XB_XGEN(j)  (2304 + 64 * (j))
#define XB_TOP      3328
#define XB_TOPGEN   3392
#define XCD_BAR_WORDS 3456
#define XB_SPIN_CAP (1u << 22)
DI unsigned xb_ld(unsigned* p)              { return __hip_atomic_load(p, __ATOMIC_RELAXED, __HIP_MEMORY_SCOPE_AGENT); }
DI unsigned xb_add(unsigned* p, unsigned v) { return __hip_atomic_fetch_add(p, v, __ATOMIC_RELAXED, __HIP_MEMORY_SCOPE_AGENT); }
DI unsigned xb_xcc_id() { return (unsigned)__builtin_amdgcn_s_getreg((3 << 11) | 20) & 0xFu; }
#define XB_SPIN(cond, bar) do { unsigned _sp = 0; while (cond) { __builtin_amdgcn_s_sleep(1); \
    if ((++_sp & 255u) == 0u) { if (xb_ld(&(bar)[XB_TMO])) break; if (_sp > XB_SPIN_CAP) { atomicAdd(&(bar)[XB_TMO], 1u); break; } } } } while (0)
struct XcdBarrier { unsigned* bar; unsigned x; volatile LAS unsigned* st; };
DI XcdBarrier xcd_barrier_post(unsigned* bar, volatile LAS unsigned* st) {
    XcdBarrier b; b.bar = bar; b.x = xb_xcc_id(); b.st = st;
    if (threadIdx.x == 0) (void)xb_add(&bar[XB_XCNT(b.x)], 1u);
    return b;
}
DI void xcd_barrier_complete(unsigned* bar, unsigned x, unsigned& nloc, unsigned& nx) {
    const unsigned G = gridDim.x * gridDim.y * gridDim.z;
    unsigned sum, cnt, mine, sp = 0u;
    for (;;) {
        sum = 0u; cnt = 0u; mine = 0u;
#pragma unroll
        for (unsigned j = 0; j < 16; ++j) { const unsigned c = xb_ld(&bar[XB_XCNT(j)]); sum += c; cnt += (c > 0u) ? 1u : 0u; mine = (j == x) ? c : mine; }
        if (sum == G) break;
        __builtin_amdgcn_s_sleep(1);
        if ((++sp & 255u) == 0u) { if (xb_ld(&bar[XB_TMO])) break; if (sp > XB_SPIN_CAP) { atomicAdd(&bar[XB_TMO], 1u); break; } }
    }
    nloc = mine > 0u ? mine : 1u; nx = cnt > 0u ? cnt : 1u;
}
DI void xcd_barrier(const XcdBarrier& b) {
    asm volatile("s_waitcnt vmcnt(0)" ::: "memory");
    __syncthreads();
    if (threadIdx.x == 0) {
        unsigned* bar = b.bar; asm volatile("" : "+s"(bar));
        __builtin_amdgcn_s_waitcnt(0);
        unsigned nloc = b.st[0], nx = b.st[1];
        if (nloc == 0u) { xcd_barrier_complete(bar, b.x, nloc, nx); b.st[0] = nloc; b.st[1] = nx; }
        const unsigned old = xb_add(&bar[XB_XSUB(b.x)], 1u);
        const unsigned gen = old / nloc;
        if (old + 1u == (gen + 1u) * nloc) {
            __builtin_amdgcn_fence(__ATOMIC_RELEASE, "agent");
            asm volatile("s_waitcnt vmcnt(0)" ::: "memory");
            const unsigned og = xb_add(&bar[XB_TOP], 1u);
            const unsigned tg = og / nx;
            if (og + 1u == (tg + 1u) * nx) xb_add(&bar[XB_TOPGEN], 1u);
            else XB_SPIN(xb_ld(&bar[XB_TOPGEN]) == tg, bar);
            __builtin_amdgcn_fence(__ATOMIC_ACQUIRE, "agent");
            xb_add(&bar[XB_XGEN(b.x)], 1u);
            asm volatile("s_waitcnt vmcnt(0)" ::: "memory");
        } else {
            XB_SPIN(xb_ld(&bar[XB_XGEN(b.x)]) == gen, bar);
            __builtin_amdgcn_fence(__ATOMIC_ACQUIRE, "agent");
            asm volatile("s_waitcnt vmcnt(0)" ::: "memory");
        }
    }
    __syncthreads();
}

DI void grp_barrier(unsigned* cnt, unsigned& gen, bool same_xcd) {
    asm volatile("s_waitcnt vmcnt(0)" ::: "memory");
    __syncthreads();
    if (threadIdx.x == 0) {
        __builtin_amdgcn_s_waitcnt(0);
        if (!same_xcd) { __builtin_amdgcn_fence(__ATOMIC_RELEASE, "agent"); asm volatile("s_waitcnt vmcnt(0)" ::: "memory"); }
        (void)xb_add(cnt, 1u);
        const unsigned target = 16u * (gen + 1u); unsigned sp = 0;
        while (xb_ld(cnt) < target) { __builtin_amdgcn_s_sleep(1); if (++sp > XB_SPIN_CAP) break; }
        __builtin_amdgcn_fence(__ATOMIC_ACQUIRE, "agent");
        asm volatile("s_waitcnt vmcnt(0)" ::: "memory");
    }
    ++gen;
    __syncthreads();
}

template <int RMAP> DI int rmap(int n) { return RMAP == 0 ? n : (RMAP == 1 ? (n >> 7) * 256 + (n & 127) : (RMAP == 2 ? (n >> 7) * 256 + 128 + (n & 127) : (n & ~31) + 8 * ((n >> 2) & 3) + 4 * ((n >> 4) & 1) + (n & 3))); }
template <int RMAP>
DI void cvt_weight(const float* W, int K, int ldw, int c0, int N, bf16_t* WT, int row_off, const float* gk, const float* gn, float scale, LAS float* scr_, int& rot, int NGW, int lane) {
    LAS bf16_t* scr = (LAS bf16_t*)scr_;
    const int nblk = N / 64, nitems = (K / 64) * nblk;
    const int first = rot; rot = (rot + NGW - nitems % NGW) % NGW;
    const int lr = lane >> 4, lc = (lane & 15) * 4;
    for (int item = first; item < nitems; item += NGW) {
        const int kb = item / nblk, nb = item % nblk, k0 = 64 * kb, n0 = 64 * nb;
        f32x4 gnv = {scale, scale, scale, scale};
        if (gn) { const f32x4 t = *(const f32x4*)(gn + n0 + lc); gnv = t * scale; }
        f32x4 v[16]; float gkq[16];
#pragma unroll
        for (int i = 0; i < 16; ++i) v[i] = *(const f32x4*)(W + (size_t)(k0 + 4 * i + lr) * ldw + c0 + n0 + lc);
#pragma unroll
        for (int i = 0; i < 16; ++i) gkq[i] = gk ? gk[k0 + 4 * i + lr] : 1.f;
        asm volatile("" ::: "memory");
#pragma unroll
        for (int i = 0; i < 16; ++i) { const int kk = 4 * i + lr; const float gkv = gkq[i]; const f32x4 o = v[i] * gnv * gkv;
            scr[(lc + 0) * 72 + kk] = (bf16_t)(cvtpk(o[0], 0.f) & 0xffffu); scr[(lc + 1) * 72 + kk] = (bf16_t)(cvtpk(o[1], 0.f) & 0xffffu);
            scr[(lc + 2) * 72 + kk] = (bf16_t)(cvtpk(o[2], 0.f) & 0xffffu); scr[(lc + 3) * 72 + kk] = (bf16_t)(cvtpk(o[3], 0.f) & 0xffffu); }
        LDS_WAIT(); asm volatile("" ::: "memory");
#pragma unroll
        for (int j = 0; j < 8; ++j) { const int n = 8 * j + (lane >> 3), c = lane & 7; const u32x4 o = *(const LAS u32x4*)(scr + n * 72 + 8 * c);
            *(u32x4*)(WT + (size_t)(row_off + rmap<RMAP>(n0 + n)) * K + k0 + 8 * c) = o; }
        LDS_WAIT(); asm volatile("" ::: "memory");
    }
}
DI void cvt_rows(const float* W, int K, bf16_t* dst, const float* gk, float scale, int& rot, int NGW, int lane) {
    const int first = rot; rot = (rot + NGW - K % NGW) % NGW;
    for (int k = first; k < K; k += NGW) { const float g = gk[k] * scale; const f32x4* xr = (const f32x4*)(W + (size_t)k * DM) + lane; u32x2* o8 = (u32x2*)(dst + (size_t)k * DM) + lane;
#pragma unroll
        for (int j = 0; j < 4; ++j) { const f32x4 v = xr[64 * j] * g; u32x2 w; w.x = cvtpk(v[0], v[1]); w.y = cvtpk(v[2], v[3]); o8[64 * j] = w; } }
}
DI void rows_to_bf16(const float* X, bf16_t* XB, float* RSTD, int nrows, float* Xcopy, int gw, int NGW, int lane) {
    asm volatile("" : "+v"(lane));
    (void)Xcopy;
    for (int row0 = 2 * gw; row0 < nrows; row0 += 2 * NGW) {
        f32x4 v[2][4]; float s[2];
#pragma unroll
        for (int k = 0; k < 2; ++k) { const f32x4* xr = (const f32x4*)(X + (size_t)(row0 + k) * DM) + lane;
#pragma unroll
            for (int j = 0; j < 4; ++j) v[k][j] = xr[64 * j]; }
#pragma unroll
        for (int k = 0; k < 2; ++k) { float q = 0.f;
#pragma unroll
            for (int j = 0; j < 4; ++j) q += (v[k][j][0] * v[k][j][0] + v[k][j][1] * v[k][j][1]) + (v[k][j][2] * v[k][j][2] + v[k][j][3] * v[k][j][3]);
            s[k] = wave_sum(q); }
#pragma unroll
        for (int k = 0; k < 2; ++k) {
            if (lane == 0) *(f32x4*)(RSTD + (size_t)(row0 + k) * 4) = (f32x4){s[k], 0.f, 0.f, 0.f};
            u32x2* o8 = (u32x2*)(XB + (size_t)(row0 + k) * DM) + lane;
#pragma unroll
            for (int j = 0; j < 4; ++j) { u32x2 w; w.x = cvtpk(v[k][j][0], v[k][j][1]); w.y = cvtpk(v[k][j][2], v[k][j][3]); o8[64 * j] = w; } }
    }
}
DI void pool_pre(const bf16_t* X, const float* SSQ, const float* gpre, bf16_t* DP, int run0, int run_end, int run_step, int tid) {
    asm volatile("" : "+v"(tid));
    const int c = 4 * (tid & 255), w = 2 << (c >> 8);
    const f32x4 g = *(const f32x4*)(gpre + c);
    for (int run = run0 + (tid >> 8) * run_step; run < run_end; run += 2 * run_step) {
        const int r0 = run * 64, tp0 = r0 & (SEQ - 1);
        f32x4 s = {0.f, 0.f, 0.f, 0.f};
        for (int j = 1; j < w; ++j) { if (tp0 - j >= 0) { const u32x2 xv = *(const u32x2*)(X + (size_t)(r0 - j) * DM + c); const float rs = rstd_of(SSQ, r0 - j);
            s += (f32x4){bflo(xv.x), bfhi(xv.x), bflo(xv.y), bfhi(xv.y)} * rs * g; } }
#pragma unroll 1
        for (int i0 = 0; i0 < 64; i0 += 8) {
            u32x2 xv[8], xl[8]; float rs[8], rl[8];
#pragma unroll
            for (int k = 0; k < 8; ++k) { const int row = r0 + i0 + k, tp = tp0 + i0 + k; const int lrow = (tp - w + 1 >= 0) ? row - w + 1 : row;
                xv[k] = *(const u32x2*)(X + (size_t)row * DM + c); rs[k] = rstd_of(SSQ, row); xl[k] = *(const u32x2*)(X + (size_t)lrow * DM + c); rl[k] = rstd_of(SSQ, lrow); }
#pragma unroll
            for (int k = 0; k < 8; ++k) { const int row = r0 + i0 + k, tp = tp0 + i0 + k;
                const f32x4 h = (f32x4){bflo(xv[k].x), bfhi(xv[k].x), bflo(xv[k].y), bfhi(xv[k].y)} * rs[k] * g;
                s += h;
                const float inv = 1.0f / (float)(tp + 1 < w ? tp + 1 : w);
                const f32x4 d = s * inv - h;
                u32x2 o; o.x = cvtpk(d[0], d[1]); o.y = cvtpk(d[2], d[3]);
                *(u32x2*)(DP + (size_t)row * DM + c) = o;
                if (tp - w + 1 >= 0) s -= (f32x4){bflo(xl[k].x), bfhi(xl[k].x), bflo(xl[k].y), bfhi(xl[k].y)} * rl[k] * g; }
        }
    }
}

#define MFMA32(a, b, c) __builtin_amdgcn_mfma_f32_32x32x16_bf16((a), (b), (c), 0, 0, 0)
#define MFMA16(a, b, c) __builtin_amdgcn_mfma_f32_16x16x32_bf16((a), (b), (c), 0, 0, 0)
#define SB_SUBTILE(Z, DIAG, ALLV, A, RUN) do { float sg_[16], kp_[16]; \
        _Pragma("unroll") for (int i = 0; i < 16; ++i) { const int ko = (i & 3) + 8 * (i >> 2) + 4 * hh; const bool valid = (ALLV) && (!(DIAG) || (ko < r)); \
              \
            const float zz = __builtin_amdgcn_fmed3f(Z[i], -126.0f, 126.0f), e = ex2(-zz), rc = __builtin_amdgcn_rcpf(1.0f + e), er = e * rc; \
            sg_[i] = valid ? rc : 0.f; kp_[i] = valid ? er : 1.f; } \
        float pg_[4], tg_[4];        \
        _Pragma("unroll") for (int g = 0; g < 4; ++g) { const float gp_ = (kp_[4 * g] * kp_[4 * g + 1]) * (kp_[4 * g + 2] * kp_[4 * g + 3]); \
            const auto sw_ = __builtin_amdgcn_permlane32_swap(__float_as_uint(gp_), __float_as_uint(gp_), false, false); const float r0_ = __uint_as_float(sw_[0]), r1_ = __uint_as_float(sw_[1]); \
            pg_[g] = r0_ * r1_; tg_[g] = hh ? 1.f : r1_; } \
        float run_ = 1.f, aft_[4]; \
        _Pragma("unroll") for (int g = 3; g >= 0; --g) { aft_[g] = run_ * tg_[g]; run_ *= pg_[g]; } \
        _Pragma("unroll") for (int g = 0; g < 4; ++g) { float c = aft_[g] * F; \
            _Pragma("unroll") for (int k = 3; k >= 0; --k) { A[4 * g + k] = sg_[4 * g + k] * c; c *= kp_[4 * g + k]; } } \
        RUN = run_; } while (0)
DI void sb_attention(const bf16_t* QK, const bf16_t* VT, bf16_t* O, LAS unsigned char* lds, int vcu, int G, int tid_in) {
    int tid = tid_in; asm volatile("" : "+v"(tid));
    const int lane = tid & 63, wave = __builtin_amdgcn_readfirstlane(tid >> 6), r = lane & 31, hh = lane >> 5;
    for (int bh = vcu; bh < NB * 16; bh += G) {
        const int h = bh & 15, b = bh >> 4;
        const bf16_t* kbase = QK + (size_t)(b * SEQ + r) * 2048 + 1024 + h * 64 + 8 * hh;
        const bf16_t* vbase = VT + ((size_t)b * 1024 + h * 64 + r) * LDT + 4 * hh;
        unsigned koff[4], voff[4];
#pragma unroll
        for (int q = 0; q < 4; ++q) { const int sl = (wave * 4 + q) * 64 + lane;
            { const int row = sl >> 3, piece = (sl & 7) ^ (row & 7); koff[q] = (unsigned)(row * 2048 + piece * 8); }
            { const int d = sl >> 5, sp = sl & 31; voff[q] = (unsigned)(d * LDT + (sp ^ (d & 15)) * 8); } }
#pragma unroll 1
        for (int unit = 0; unit < SEQ / 256; ++unit) {
            const int T0 = unit * 256, half = unit & 1, t0 = T0 + wave * 32;
            const bf16_t* qp = QK + (size_t)(b * SEQ + t0 + r) * 2048 + h * 64 + 8 * hh;
            bf16x8 qf[4];
#pragma unroll
            for (int s = 0; s < 4; ++s) qf[s] = *(const bf16x8*)(qp + 16 * s);
            asm volatile("s_waitcnt lgkmcnt(0)" ::: "memory"); __builtin_amdgcn_s_barrier(); asm volatile("" ::: "memory");
            {   const bf16_t* ksrc = QK + (size_t)(b * SEQ + T0) * 2048 + 1024 + h * 64; const bf16_t* vsrc = VT + ((size_t)b * 1024 + h * 64) * LDT + T0;
#pragma unroll
                for (int q = 0; q < 4; ++q) {
                    __builtin_amdgcn_global_load_lds((const unsigned*)(ksrc + koff[q]), (LAS unsigned*)(lds + half * 32768 + (wave * 4 + q) * 1024), 16, 0, 0);
                    __builtin_amdgcn_global_load_lds((const unsigned*)(vsrc + voff[q]), (LAS unsigned*)(lds + 65536 + half * 32768 + (wave * 4 + q) * 1024), 16, 0, 0); } }
            asm volatile("s_waitcnt vmcnt(0)" ::: "memory"); __builtin_amdgcn_s_barrier(); asm volatile("" ::: "memory");
            const int ring_lo = T0 >= 256 ? T0 - 256 : 0;
            f32x16 o0, o1;
#pragma unroll
            for (int i = 0; i < 16; ++i) { o0[i] = 0.f; o1[i] = 0.f; }
            float F = 1.f, R = 0.f;
            int sb = t0 - 32;
            for (;;) {
                const bool lval = sb >= 0; const int sbl = lval ? sb : 0, sbh = sb + 32;
                bf16x8 kH[4], kL[4]; bf16x4 vH[2][2][2], vL[2][2][2];
                if (sbl >= ring_lo) {
                    const int rh = (sbh + r) & 511, rl = (sbl + r) & 511;
#pragma unroll
                    for (int s = 0; s < 4; ++s) { kH[s] = *(const LAS bf16x8*)(lds + rh * 128 + (((2 * s + hh) ^ (rh & 7)) << 4)); kL[s] = *(const LAS bf16x8*)(lds + rl * 128 + (((2 * s + hh) ^ (rl & 7)) << 4)); }
#pragma unroll
                    for (int dt = 0; dt < 2; ++dt)
#pragma unroll
                        for (int s = 0; s < 2; ++s)
#pragma unroll
                            for (int p = 0; p < 2; ++p) { const int d = 32 * dt + r; const int ph = ((sbh & 255) >> 3) + 2 * s + p, pl = ((sbl & 255) >> 3) + 2 * s + p;
                                vH[dt][s][p] = *(const LAS bf16x4*)(lds + 65536 + ((sbh >> 8) & 1) * 32768 + d * 512 + ((ph ^ (d & 15)) << 4) + hh * 8);
                                vL[dt][s][p] = *(const LAS bf16x4*)(lds + 65536 + ((sbl >> 8) & 1) * 32768 + d * 512 + ((pl ^ (d & 15)) << 4) + hh * 8); }
                } else {
#pragma unroll
                    for (int s = 0; s < 4; ++s) { kH[s] = *(const bf16x8*)(kbase + (size_t)sbh * 2048 + 16 * s); kL[s] = *(const bf16x8*)(kbase + (size_t)sbl * 2048 + 16 * s); }
#pragma unroll
                    for (int dt = 0; dt < 2; ++dt)
#pragma unroll
                        for (int s = 0; s < 2; ++s)
#pragma unroll
                            for (int p = 0; p < 2; ++p) { vH[dt][s][p] = *(const bf16x4*)(vbase + (size_t)dt * 32 * LDT + sbh + 16 * s + 8 * p); vL[dt][s][p] = *(const bf16x4*)(vbase + (size_t)dt * 32 * LDT + sbl + 16 * s + 8 * p); }
                }
                const int nsb = sb - 64; const bool more = nsb >= -32;
                f32x16 zH, zL;
#pragma unroll
                for (int i = 0; i < 16; ++i) { zH[i] = 0.f; zL[i] = 0.f; }
#pragma unroll
                for (int s = 0; s < 4; ++s) { zH = MFMA32(kH[s], qf[s], zH); zL = MFMA32(kL[s], qf[s], zL); }
                float aH[16], aL[16], runH, runL;
                if (sbh == t0) SB_SUBTILE(zH, true, true, aH, runH); else SB_SUBTILE(zH, false, true, aH, runH);
                F *= runH;
                if (lval) SB_SUBTILE(zL, false, true, aL, runL);
                else {
#pragma unroll
                    for (int i = 0; i < 16; ++i) aL[i] = 0.f;
                    runL = 1.f; }
                F *= runL;
                R -= lg2(runH) + lg2(runL);
#pragma unroll
                for (int s = 0; s < 2; ++s) {
                    u32x4 w; w.x = cvtpk(aH[8 * s + 0], aH[8 * s + 1]); w.y = cvtpk(aH[8 * s + 2], aH[8 * s + 3]); w.z = cvtpk(aH[8 * s + 4], aH[8 * s + 5]); w.w = cvtpk(aH[8 * s + 6], aH[8 * s + 7]);
                    const bf16x8 pH = __builtin_bit_cast(bf16x8, w);
                    w.x = cvtpk(aL[8 * s + 0], aL[8 * s + 1]); w.y = cvtpk(aL[8 * s + 2], aL[8 * s + 3]); w.z = cvtpk(aL[8 * s + 4], aL[8 * s + 5]); w.w = cvtpk(aL[8 * s + 6], aL[8 * s + 7]);
                    const bf16x8 pL = __builtin_bit_cast(bf16x8, w);
                    o0 = MFMA32(__builtin_shufflevector(vH[0][s][0], vH[0][s][1], 0, 1, 2, 3, 4, 5, 6, 7), pH, o0); o1 = MFMA32(__builtin_shufflevector(vH[1][s][0], vH[1][s][1], 0, 1, 2, 3, 4, 5, 6, 7), pH, o1);
                    o0 = MFMA32(__builtin_shufflevector(vL[0][s][0], vL[0][s][1], 0, 1, 2, 3, 4, 5, 6, 7), pL, o0); o1 = MFMA32(__builtin_shufflevector(vL[1][s][0], vL[1][s][1], 0, 1, 2, 3, 4, 5, 6, 7), pL, o1); }
                if (!more) break;
                if (__all(R >= 151.0f)) break;
                sb = nsb;
            }
            bf16_t* op = O + (size_t)(b * SEQ + t0 + r) * DM + h * 64 + 4 * hh;
#pragma unroll
            for (int g = 0; g < 4; ++g) {
                u32x2 w; w.x = cvtpk(o0[4 * g], o0[4 * g + 1]); w.y = cvtpk(o0[4 * g + 2], o0[4 * g + 3]); *(u32x2*)(op + 8 * g) = w;
                w.x = cvtpk(o1[4 * g], o1[4 * g + 1]); w.y = cvtpk(o1[4 * g + 2], o1[4 * g + 3]); *(u32x2*)(op + 32 + 8 * g) = w; }
        }
        asm volatile("s_waitcnt lgkmcnt(0)" ::: "memory"); __builtin_amdgcn_s_barrier(); asm volatile("" ::: "memory");
    }
}

DI void ret_scores(const bf16_t* QKn, bf16_t* SC, int u0, int u_end, int u_step, int lane) {
    asm volatile("" : "+v"(lane));
    const int fr = lane & 15, fq = lane >> 4;
    for (int u = u0; u < u_end; u += u_step) {
        const int c = u & 63, h = (u >> 6) & 3, bl = u >> 8;
        const bf16_t* qb = QKn + (size_t)(bl * SEQ + c * 64) * 2048 + h * 256 + 8 * fq;
        const bf16_t* kbp = qb + 1024;
        bf16_t* sc = SC + (size_t)u * 4096;
#pragma unroll 1
        for (int nt = 0; nt < 4; ++nt) {
            bf16x8 qf[8];
#pragma unroll
            for (int ks = 0; ks < 8; ++ks) qf[ks] = *(const bf16x8*)(qb + (size_t)(16 * nt + fr) * 2048 + 32 * ks);
#pragma unroll 1
            for (int mt = 0; mt < 4; ++mt) {
                f32x4 acc = {0.f, 0.f, 0.f, 0.f};
                if (mt <= nt) {
#pragma unroll
                    for (int ks = 0; ks < 8; ++ks) { const bf16x8 kr = *(const bf16x8*)(kbp + (size_t)(16 * mt + fr) * 2048 + 32 * ks); const bf16x8 kf = (fr & 8) ? __builtin_shufflevector(kr, kr, 4, 5, 6, 7, 0, 1, 2, 3) : kr;     acc = MFMA16(kf, qf[ks], acc); }
                    const int n = 16 * nt + fr;
#pragma unroll
                    for (int i = 0; i < 4; ++i) { const int m = 16 * mt + 4 * fq + i; acc[i] = (n >= m) ? acc[i] : 0.f; }
                }
                u32x2 w; w.x = cvtpk(acc[0], acc[1]); w.y = cvtpk(acc[2], acc[3]);
                *(u32x2*)(sc + (16 * nt + fr) * 64 + 16 * mt + 4 * fq) = w;
            }
        }
    }
}
DI void ret_scan(const bf16_t* QKn, const bf16_t* KVT, const bf16_t* SC, bf16_t* O, float* gns, LAS unsigned char* lds, int vcu, int G, int tid_in) {
    int tid = tid_in; asm volatile("" : "+v"(tid));
    const int lane = tid & 63, wave = __builtin_amdgcn_readfirstlane(tid >> 6), fr = lane & 15, fq = lane >> 4;
    LAS unsigned char* OUT = lds + SMX_OFF;
    constexpr int OUTP = 272;
    for (int task = vcu; task < NB * 16; task += G) {
        const int eb = task & 3, h = (task >> 2) & 3, bl = task >> 4, e0 = eb * 128 + wave * 16;
        const float g64 = ex2(64.0f * lg2(1.0f - ex2(-5.0f - (float)h)));
        const bf16_t* qsrc = QKn + (size_t)(bl * SEQ) * 2048 + h * 256;
        const bf16_t* vtp = KVT + (size_t)bl * 2048 * LDR + (size_t)(h * 512 + e0 + fr) * LDR + 8 * fq;
        const bf16_t* scp = SC + (size_t)((bl * 4 + h) * 64) * 4096 + fr * 64 + 8 * fq;
        bf16_t* ob = O + (size_t)(bl * SEQ) * 2048 + h * 512 + eb * 128;
#define RS_DMA(c_, buf_) do { int ln_ = lane; asm volatile("" : "+v"(ln_)); _Pragma("unroll") for (int q = 0; q < 4; ++q) { const int sl = (wave * 4 + q) * 64 + ln_, row = sl >> 5; \
            const unsigned qo = (unsigned)(row * 2048 + (((sl & 31) ^ (row & 15)) << 3)), ko = (unsigned)(row * 2048 + (((sl & 31) ^ ((row & 3) << 2)) << 3)) + 1024u;     \
            __builtin_amdgcn_global_load_lds((const unsigned*)(qsrc + (size_t)(c_) * 64 * 2048 + qo), (LAS unsigned*)(lds + (buf_) * 65536 + (wave * 4 + q) * 1024), 16, 0, 0); \
            __builtin_amdgcn_global_load_lds((const unsigned*)(qsrc + (size_t)(c_) * 64 * 2048 + ko), (LAS unsigned*)(lds + (buf_) * 65536 + 32768 + (wave * 4 + q) * 1024), 16, 0, 0); } } while (0)
#define RS_STORE_OUT(c_) do { _Pragma("unroll") for (int q = 0; q < 2; ++q) { const int idx = tid + 512 * q, p = idx >> 4, pc = idx & 15; \
            const u32x4 v = *(const LAS u32x4*)(OUT + p * OUTP + pc * 16); *(u32x4*)(ob + (size_t)(p * 64 + (c_)) * 2048 + pc * 8) = v; \
            const float a0 = bflo(v.x), a1 = bfhi(v.x), a2 = bflo(v.y), a3 = bfhi(v.y), a4 = bflo(v.z), a5 = bfhi(v.z), a6 = bflo(v.w), a7 = bfhi(v.w); \
            float s1 = ((a0 + a1) + (a2 + a3)) + ((a4 + a5) + (a6 + a7)), s2 = ((a0 * a0 + a1 * a1) + (a2 * a2 + a3 * a3)) + ((a4 * a4 + a5 * a5) + (a6 * a6 + a7 * a7)); \
            s1 = rowsum16(s1); s2 = rowsum16(s2); \
            if (pc == 0) *(f32x2*)(gns + (size_t)(bl * SEQ + p * 64 + (c_)) * 32 + h * 8 + eb * 2) = (f32x2){s1, s2}; } } while (0)
        f32x4 S[16];
#pragma unroll
        for (int T = 0; T < 16; ++T) S[T] = (f32x4){0.f, 0.f, 0.f, 0.f};
        bf16x8 scr[8], vcur[2], vnext[2];
        RS_DMA(0, 0);
#pragma unroll
        for (int k2 = 0; k2 < 2; ++k2) { vcur[k2] = *(const bf16x8*)(vtp + 32 * k2); vnext[k2] = vcur[k2]; }
#pragma unroll
        for (int k2 = 0; k2 < 2; ++k2)
#pragma unroll
            for (int nt = 0; nt < 4; ++nt) scr[k2 * 4 + nt] = *(const bf16x8*)(scp + (16 * nt) * 64 + 32 * k2);
#pragma unroll 1
        for (int c = 0; c < 64; ++c) {
            asm volatile("s_waitcnt vmcnt(0) lgkmcnt(0)" ::: "memory"); __builtin_amdgcn_s_barrier(); asm volatile("" ::: "memory");
            const int buf = c & 1;
            if (c + 1 < 64) { RS_DMA(c + 1, buf ^ 1);
#pragma unroll
                for (int k2 = 0; k2 < 2; ++k2) vnext[k2] = *(const bf16x8*)(vtp + (c + 1) * 64 + 32 * k2); }
            if (c > 0) RS_STORE_OUT(c - 1);
            const LAS unsigned char* Qb = lds + buf * 65536; LAS unsigned char* Kb = lds + buf * 65536 + 32768;
            int q4 = fr >> 2; asm volatile("" : "+v"(q4));
            LAS unsigned char* krow = Kb + (8 * fq + q4) * 512 + (fr & 3) * 16;
            f32x4 acc[4];
#pragma unroll
            for (int nt = 0; nt < 4; ++nt) acc[nt] = (f32x4){0.f, 0.f, 0.f, 0.f};
            bf16x8 aQ[3][4];
#define RS_QREAD(bufi, KS) do { const unsigned qa_ = (unsigned)(size_t)(Qb + fr * 512 + (((4 * (KS) + fq) ^ fr) << 4)); \
                asm volatile("ds_read_b128 %0, %1" : "=v"(aQ[bufi][0]) : "v"(qa_)); asm volatile("ds_read_b128 %0, %1 offset:8192" : "=v"(aQ[bufi][1]) : "v"(qa_)); \
                asm volatile("ds_read_b128 %0, %1 offset:16384" : "=v"(aQ[bufi][2]) : "v"(qa_)); asm volatile("ds_read_b128 %0, %1 offset:24576" : "=v"(aQ[bufi][3]) : "v"(qa_)); } while (0)
#define RS_QWAIT(bufi, N) asm volatile("s_waitcnt lgkmcnt(" #N ")" : "+v"(aQ[bufi][0]), "+v"(aQ[bufi][1]), "+v"(aQ[bufi][2]), "+v"(aQ[bufi][3]))
            RS_QREAD(0, 0); RS_QREAD(1, 1);
#pragma unroll
            for (int ks = 0; ks < 8; ++ks) {
                if (ks < 6) { RS_QREAD((ks + 2) % 3, ks + 2); RS_QWAIT(ks % 3, 8); }
                else if (ks == 6) RS_QWAIT(ks % 3, 4);
                else RS_QWAIT(ks % 3, 0);
                u32x4 w; w.x = cvtpk(S[2 * ks][0], S[2 * ks][1]); w.y = cvtpk(S[2 * ks][2], S[2 * ks][3]); w.z = cvtpk(S[2 * ks + 1][0], S[2 * ks + 1][1]); w.w = cvtpk(S[2 * ks + 1][2], S[2 * ks + 1][3]);
                const bf16x8 bS = __builtin_bit_cast(bf16x8, w);
#pragma unroll
                for (int nt = 0; nt < 4; ++nt) acc[nt] = MFMA16(bS, aQ[ks % 3][nt], acc[nt]);
            }
#undef RS_QREAD
#undef RS_QWAIT
#pragma unroll
            for (int nt = 0; nt < 4; ++nt) acc[nt] *= g64;
#pragma unroll
            for (int k2 = 0; k2 < 2; ++k2)
#pragma unroll
                for (int nt = 0; nt < 4; ++nt) acc[nt] = MFMA16(vcur[k2], scr[k2 * 4 + nt], acc[nt]);
            if (c + 1 < 64) {
#pragma unroll
                for (int k2 = 0; k2 < 2; ++k2)
#pragma unroll
                    for (int nt = 0; nt < 4; ++nt) scr[k2 * 4 + nt] = *(const bf16x8*)(scp + (size_t)(c + 1) * 4096 + (16 * nt) * 64 + 32 * k2); }
            asm volatile("s_waitcnt lgkmcnt(0)" ::: "memory"); __builtin_amdgcn_s_barrier(); asm volatile("" ::: "memory");
#pragma unroll
            for (int nt = 0; nt < 4; ++nt) { u32x2 w; w.x = cvtpk(acc[nt][0], acc[nt][1]); w.y = cvtpk(acc[nt][2], acc[nt][3]);
                *(LAS u32x2*)(OUT + (16 * nt + fr) * OUTP + wave * 32 + fq * 8) = w; }
            const int hsw8 = (fq & 1) * 8;
            bf16x4 kf[4][4];
#define RS_KREAD(bufi, TT) do { const unsigned ka_ = (unsigned)(size_t)(krow + (((((TT) >> 1) ^ q4) << 6) + ((((TT) & 1) * 8) ^ hsw8))); \
                asm volatile("ds_read_b64_tr_b16 %0, %1" : "=v"(kf[bufi][0]) : "v"(ka_)); asm volatile("ds_read_b64_tr_b16 %0, %1 offset:2048" : "=v"(kf[bufi][1]) : "v"(ka_)); \
                asm volatile("ds_read_b64_tr_b16 %0, %1 offset:16384" : "=v"(kf[bufi][2]) : "v"(ka_)); asm volatile("ds_read_b64_tr_b16 %0, %1 offset:18432" : "=v"(kf[bufi][3]) : "v"(ka_)); } while (0)
#define RS_KWAIT(bufi, N) asm volatile("s_waitcnt lgkmcnt(" #N ")" : "+v"(kf[bufi][0]), "+v"(kf[bufi][1]), "+v"(kf[bufi][2]), "+v"(kf[bufi][3]))
            RS_KREAD(0, 0); RS_KREAD(1, 1); RS_KREAD(2, 2);
#pragma unroll
            for (int T = 0; T < 16; ++T) {
                if (T < 13) { RS_KREAD((T + 3) & 3, T + 3); RS_KWAIT(T & 3, 12); }
                else if (T == 13) RS_KWAIT(T & 3, 8);
                else if (T == 14) RS_KWAIT(T & 3, 4);
                else RS_KWAIT(T & 3, 0);
                f32x4 sv = S[T] * g64;
#pragma unroll
                for (int k2 = 0; k2 < 2; ++k2) { const bf16x8 aK = __builtin_shufflevector(kf[T & 3][2 * k2], kf[T & 3][2 * k2 + 1], 0, 1, 2, 3, 4, 5, 6, 7); sv = MFMA16(aK, vcur[k2], sv); }
                S[T] = sv;
            }
#undef RS_KWAIT
#undef RS_KREAD
            vcur[0] = vnext[0]; vcur[1] = vnext[1];
        }
        asm volatile("s_waitcnt vmcnt(0) lgkmcnt(0)" ::: "memory"); __builtin_amdgcn_s_barrier(); asm volatile("" ::: "memory");
        RS_STORE_OUT(63);
        asm volatile("s_waitcnt lgkmcnt(0)" ::: "memory"); __builtin_amdgcn_s_barrier(); asm volatile("" ::: "memory");
#undef RS_DMA
#undef RS_STORE_OUT
    }
}
DI GAS unsigned char* opq(unsigned char* p) { GAS unsigned char* q = (GAS unsigned char*)p; asm volatile("" : "+s"(q)); return q; }
struct Args { const float* in[21]; float* out; unsigned char* ws; };
static_assert(sizeof(Args) == 23 * 8, "no padding");

__global__ void __launch_bounds__(512, 2) fwd_kernel(Args args) {
    extern __shared__ __attribute__((aligned(16))) unsigned char lds_raw[];
    LAS unsigned char* lds = (LAS unsigned char*)lds_raw;
    volatile LAS unsigned* MISC = (volatile LAS unsigned*)(lds + MISC_OFF);
    const int tid = threadIdx.x, lane = tid & 63, wave = __builtin_amdgcn_readfirstlane(tid >> 6);
    const int G = gridDim.x, bx = blockIdx.x, vcu = (G % 8 == 0) ? (bx % 8) * (G / 8) + bx / 8 : bx;
    const int gw = vcu * 8 + wave, NGW = G * 8;
    const int grp = vcu >> 4, wg16 = vcu & 15;
    unsigned char* ws = args.ws;
    unsigned* ctl = (unsigned*)(ws + WS_CTL);
    for (int u = tid; u < 64; u += 512) ((LAS unsigned*)(lds + MISC_OFF))[u] = 0u;
    __syncthreads();
    XcdBarrier bar = xcd_barrier_post(ctl + CW_BAR, MISC + 8);
#define GRID_BAR() xcd_barrier(bar)
    if (tid == 0) (void)__hip_atomic_fetch_or(ctl + CW_GRP + 64 * (16 + (vcu >> 4)), 1u << xb_xcc_id(), __ATOMIC_RELAXED, __HIP_MEMORY_SCOPE_AGENT);

    const float* x_in = args.in[0]; const float* mem = args.in[1];
    const float* n_mix_pre = args.in[2]; const float* n_mix_post = args.in[3]; const float* n_xa_pre = args.in[4]; const float* n_xa_post = args.in[5];
    const float* n_mem = args.in[6]; const float* n_ffn_pre = args.in[7]; const float* n_ffn_post = args.in[8];
    const float* pool_w = args.in[9]; const float* pool_scale = args.in[10]; const float* sb_w_in = args.in[11]; const float* sb_w_out = args.in[12];
    const float* ret_w_in = args.in[13]; const float* ret_gn = args.in[14]; const float* ret_w_out = args.in[15];
    const float* xa_w_q = args.in[16]; const float* xa_w_kv = args.in[17]; const float* xa_w_o = args.in[18]; const float* ffn_w_in = args.in[19]; const float* ffn_w_out = args.in[20];
    float* X = args.out;
#define RSTD  ((float*)(GAS float*)(opq(ws) + WS_SSQ))
#define MRSTD ((float*)(GAS float*)(opq(ws) + WS_MRSTD))
#define cosN  ((float*)(GAS float*)(opq(ws) + WS_ROPE))
#define sinN  ((float*)(GAS float*)(opq(ws) + WS_ROPE + 2 * MiB))
#define cosT  ((float*)(GAS float*)(opq(ws) + WS_ROPE + 4 * MiB))
#define sinT  ((float*)(GAS float*)(opq(ws) + WS_ROPE + 6 * MiB))
#define MEMB  ((bf16_t*)(GAS bf16_t*)(opq(ws) + WS_MEMB))
#define KMEM  ((bf16_t*)(GAS bf16_t*)(opq(ws) + WS_KMEM))
#define VTMEM ((bf16_t*)(GAS bf16_t*)(opq(ws) + WS_VTMEM))
#define WB    ((bf16_t*)(GAS bf16_t*)(opq(ws) + WS_WB))
#define XB    ((bf16_t*)(GAS bf16_t*)(opq(ws) + WS_XB))
#define R     ((unsigned char*)(opq(ws) + WS_R))

    {
        LAS float* scr = (LAS float*)(lds + wave * 16384); int rot = gw;
        for (int j = 0; j < 2; ++j) {
            for (int g = 0; g < 4; ++g)
                cvt_weight<0>(pool_w + (size_t)(j * 4 + g) * 65536, 256, 256, 0, 256, WB + WO_POOL + (size_t)(j * 4 + g) * 65536, 0, nullptr, pool_scale + j * DM + g * 256, 1.f, scr, rot, NGW, lane);
        }
        cvt_weight<0>(sb_w_in, 1024, 3072, 0, 1024, WB + WO_SB_QK, 0, n_mix_pre + 1 * DM, nullptr, 0.125f * LOG2E, scr, rot, NGW, lane);
        cvt_weight<0>(sb_w_in, 1024, 3072, 1024, 1024, WB + WO_SB_QK, 1024, n_mix_pre + 1 * DM, nullptr, 1.f, scr, rot, NGW, lane);
        cvt_weight<0>(sb_w_in, 1024, 3072, 2048, 1024, WB + WO_SB_V, 0, n_mix_pre + 1 * DM, nullptr, 1.f, scr, rot, NGW, lane);
        cvt_weight<0>(sb_w_out, 1024, 1024, 0, 1024, WB + WO_SB_O, 0, nullptr, nullptr, 1.f, scr, rot, NGW, lane);
        cvt_weight<3>(ret_w_in, 1024, 6144, 0, 1024, WB + WO_RT_QK, 0, n_mix_pre + 2 * DM, nullptr, 1.f, scr, rot, NGW, lane);
        cvt_weight<3>(ret_w_in, 1024, 6144, 1024, 1024, WB + WO_RT_QK, 1024, n_mix_pre + 2 * DM, nullptr, 0.0625f, scr, rot, NGW, lane);
        cvt_weight<0>(ret_w_in, 1024, 6144, 2048, 2048, WB + WO_RT_KV, 0, n_mix_pre + 2 * DM, nullptr, 1.f, scr, rot, NGW, lane);
        cvt_weight<0>(ret_w_in, 1024, 6144, 4096, 2048, WB + WO_RT_G, 0, n_mix_pre + 2 * DM, nullptr, 1.f, scr, rot, NGW, lane);
        cvt_weight<0>(ret_w_out, 2048, 1024, 0, 1024, WB + WO_RT_O, 0, nullptr, nullptr, 1.f, scr, rot, NGW, lane);
        for (int i = 0; i < DEPTH; ++i) {
            cvt_rows(xa_w_q + (size_t)i * 1048576, 1024, WB + WO_XA_Q + (size_t)i * 1048576, n_xa_pre + i * DM, 0.0625f * LOG2E, rot, NGW, lane);
            cvt_weight<0>(xa_w_kv + (size_t)i * 2097152, 1024, 2048, 0, 1024, WB + WO_XA_K + (size_t)i * 1048576, 0, n_mem + i * DM, nullptr, 1.f, scr, rot, NGW, lane);
            cvt_weight<0>(xa_w_kv + (size_t)i * 2097152, 1024, 2048, 1024, 1024, WB + WO_XA_V + (size_t)i * 1048576, 0, n_mem + i * DM, nullptr, 1.f, scr, rot, NGW, lane);
            cvt_weight<0>(xa_w_o + (size_t)i * 1048576, 1024, 1024, 0, 1024, WB + WO_XA_O + (size_t)i * 1048576, 0, nullptr, nullptr, 1.f, scr, rot, NGW, lane);
            cvt_weight<1>(ffn_w_in + (size_t)i * 1024 * 5632, 1024, 5632, 0, 2816, WB + WO_FF_IN + (size_t)i * 5632 * 1024, 0, n_ffn_pre + i * DM, nullptr, 1.f, scr, rot, NGW, lane);
            cvt_weight<2>(ffn_w_in + (size_t)i * 1024 * 5632, 1024, 5632, 2816, 2816, WB + WO_FF_IN + (size_t)i * 5632 * 1024, 0, n_ffn_pre + i * DM, nullptr, 1.f, scr, rot, NGW, lane);
            cvt_weight<0>(ffn_w_out + (size_t)i * 2816 * 1024, 2816, 1024, 0, 1024, WB + WO_FF_OUT + (size_t)i * 1024 * 2816, 0, nullptr, nullptr, 1.f, scr, rot, NGW, lane);
        }
        for (int e = bx * 512 + tid; e < SEQ * 128; e += G * 512) {
            const int t = e >> 7, d = e & 127;
            const double invf = exp2(-(double)d * (13.287712379549449 / 128.0));
            double rev = (double)t * invf * 0.15915494309189535; rev -= floor(rev);
            const float c = __builtin_amdgcn_cosf((float)rev), s = __builtin_amdgcn_sinf((float)rev);
            cosN[e] = c; sinN[e] = s; cosT[(size_t)d * SEQ + t] = c; sinT[(size_t)d * SEQ + t] = s;
        }
        for (int e = bx * 512 + tid; e < (int)(2 * MiB / 16); e += G * 512) ((u32x4*)(GAS u32x4*)(opq(ws) + WS_XCH))[e] = (u32x4){0u, 0u, 0u, 0u};
        rows_to_bf16(x_in, XB, RSTD, NTOK, nullptr, gw, NGW, lane);
        rows_to_bf16(mem, MEMB, MRSTD, NMEM, nullptr, gw, NGW, lane);
    }
    GRID_BAR();
    {
        pg8::Gemm g = pg8::mk_gemm(MEMB, WB + WO_XA_K, 1024, 1024, 1024, 16, 16, 0, 256 * 1024, 0, 30);
        pg8::StaticOrder S; S.init(16, 16, G, bx);
        pg8::EpiStore E{KMEM, 4096, MRSTD, nullptr, 30, 0};
        pg8::gemm_phase(lds, g, S, E);
    }
    {
        pg8::Gemm g = pg8::mk_gemm(MEMB, WB + WO_XA_V, 1024, 1024, 1024, 16, 16, 0, 256 * 1024, 0, 30);
        pg8::StaticOrder S; S.init(16, 16, G, bx);
        pg8::EpiStore E{VTMEM, 4096, MRSTD, nullptr, 30, 0};
        pg8::gemm_phase(lds, g, S, E);
    }
    GRID_BAR();

    unsigned ggen = 0;
    const bool same_xcd = __builtin_popcount((unsigned)__builtin_amdgcn_readfirstlane(xb_ld(ctl + CW_GRP + 64 * (16 + grp)))) == 1;
#define GROUP_BAR() grp_barrier(ctl + CW_GRP + 64 * grp, ggen, same_xcd)
#define SCRB ((unsigned char*)(opq(ws) + WS_MB + (size_t)grp * (40 * MiB)))
#define SCR_ROWS(off, ld) ((bf16_t*)(SCRB + (off)) - (size_t)grp * SEQ * (ld))
#define SCR_BAT(off, per) ((bf16_t*)(SCRB + (off)) - (size_t)grp * (per))
#define XCH_P(rowoff) ((unsigned long long*)(GAS unsigned long long*)(opq(ws) + WS_XCH) + (size_t)(rowoff) * 4)
static_assert(pg8::WGM * 4 * pg8::NXCD == 256, "fused post-norm exchange: with 256 workgroups, WGM * nN(=4) units per (XCD slice, round) must be exactly one 8-panel group, so that a row panel's four column tiles are always dealt in the SAME round (else the owners wait for each other across rounds: deadlock until the spin cap)");
#define FUSED_OUT(GDESC, NM, SUB, PBASE, ROWOFF, GPOST, OUT32) do { \
        pg8::Gemm g = pg8::mk_gemm GDESC; pg8::GroupOrder S; S.init(true, 16, 4, 4, 4, grp, wg16); \
        pg8::EpiNormRes E{XB + (size_t)(ROWOFF) * DM, XB + (size_t)(ROWOFF) * DM, (OUT32), RSTD + (size_t)(ROWOFF) * 4, (GPOST), XCH_P(ROWOFF), (unsigned)((SUB) + 1), lds + SMX_OFF}; \
        pg8::gemm_phase(lds, g, S, E); } while (0)
#pragma unroll 1
    for (int layer = 0; layer < DEPTH; ++layer) {
        const int kind = layer % 3, j = layer / 3;
        if (kind == 0) {
            bf16_t* DP = SCR_ROWS(0, 1024);
            pool_pre(XB, RSTD, n_mix_pre + layer * DM, DP, 64 * grp + wg16, 64 * grp + 64, 16, tid);
            GROUP_BAR();
            FUSED_OUT((DP, WB + WO_POOL + (size_t)j * 262144, 1024, 256, 256, 256, 4, 256, 65536, 0, 30), 256, layer * 3, 0, 0, n_mix_post + layer * DM, nullptr);
        } else if (kind == 1) {
            bf16_t* QK = SCR_ROWS(0, 2048); bf16_t* VT = SCR_BAT(16 * MiB, (size_t)1024 * LDT); bf16_t* AO = SCR_ROWS(25 * MiB, 1024);
            {
                pg8::Gemm g = pg8::mk_gemm(XB, WB + WO_SB_QK, 1024, 1024, 1024, 256, 8, 0, 256 * 1024, 0, 30);
                pg8::GroupOrder S; S.init(true, 16, 8, 4, 4, grp, wg16);
                pg8::EpiStore E{QK, 2048, RSTD, nullptr, 30, 0};
                pg8::gemm_phase(lds, g, S, E);
            }
            {
                pg8::Gemm g = pg8::mk_gemm(WB + WO_SB_V, XB, 1024, 1024, 1024, 4, 256, 0, 256 * 1024, 0, 30);
                pg8::GroupOrder S; S.init(false, 16, 4, 4, 4, grp, wg16);
                pg8::EpiStore E{VT, LDT, nullptr, RSTD, 4, (long)1024 * LDT};
                pg8::gemm_phase(lds, g, S, E);
            }
            GROUP_BAR();
            sb_attention(QK, VT, AO, lds, vcu, G, tid);
            GROUP_BAR();
            FUSED_OUT((AO, WB + WO_SB_O, 1024, 1024, 1024, 256, 4, 0, 256 * 1024, 0, 30), 256, layer * 3, 0, 0, n_mix_post + layer * DM, nullptr);
        } else {
            bf16_t* QKn = (bf16_t*)X; bf16_t* KVT = SCR_BAT(0, (size_t)2048 * LDR); bf16_t* RO = SCR_ROWS(17 * MiB, 2048);
            bf16_t* SC = (bf16_t*)(GAS bf16_t*)(opq(ws) + WS_SC); float* GNS = (float*)(GAS float*)(opq(ws) + WS_MEMB);
            {
                pg8::Gemm g = pg8::mk_gemm(XB, WB + WO_RT_QK, 1024, 1024, 1024, 256, 8, 0, 256 * 1024, 0, 30);
                pg8::GroupOrder S; S.init(true, 16, 8, 4, 4, grp, wg16);
                pg8::EpiRetQK E{QKn, 2048, RSTD, cosN, sinN};
                pg8::gemm_phase(lds, g, S, E);
            }
            {
                pg8::Gemm g = pg8::mk_gemm(WB + WO_RT_KV, XB, 1024, 1024, 1024, 8, 256, 0, 256 * 1024, 0, 30);
                pg8::GroupOrder S; S.init(false, 16, 8, 4, 4, grp, wg16);
                pg8::EpiRetKVT E{KVT, RSTD};
                pg8::gemm_phase(lds, g, S, E);
            }
            GROUP_BAR();
            ret_scores(QKn, SC, 256 * grp + wg16 * 8 + wave, 256 * grp + 256, 128, lane);
            GROUP_BAR();
            ret_scan(QKn, KVT, SC, RO, GNS, lds, vcu, G, tid);
            GROUP_BAR();
            {
                pg8::Gemm g = pg8::mk_gemm(XB, WB + WO_RT_G, 1024, 1024, 1024, 256, 8, 0, 256 * 1024, 0, 30);
                pg8::GroupOrder S; S.init(true, 16, 8, 4, 4, grp, wg16);
                pg8::EpiRetGate E{RO, 2048, RSTD, GNS, ret_gn};
                pg8::gemm_phase(lds, g, S, E);
            }
            GROUP_BAR();
            FUSED_OUT((RO, WB + WO_RT_O, 2048, 2048, 2048, 256, 4, 0, 256 * 2048, 0, 30), 256, layer * 3, 0, 0, n_mix_post + layer * DM, nullptr);
        }
        {
            bf16_t* P = SCR_ROWS(0, 1024); bf16_t* MT = SCR_BAT(34 * MiB, (size_t)1024 * 1024); bf16_t* NT = SCR_BAT(36 * MiB, (size_t)1024 * 1024);
            {
                pg8::Gemm g{KMEM + (size_t)layer * 1024, WB + WO_XA_Q + (size_t)layer * 1048576, 4096, 1024, 256, 64, 4, 2, 30, 256, (long)256 * 4096, 0, 0, 256, 0, (long)256 * 1024, 0};
                pg8::GroupOrder S; S.init(true, 4, 4, 4, 4, grp, wg16);
                pg8::EpiStore E{MT, 1024, nullptr, nullptr, 30, 0};
                pg8::gemm_phase(lds, g, S, E);
            }
            {
                pg8::Gemm g{WB + WO_XA_O + (size_t)layer * 1048576, VTMEM + (size_t)layer * 1024, 1024, 4096, 256, 4, 64, 30, 2, (long)256 * 1024, 0, 256, 0, 0, 0, 256, (long)256 * 4096};
                pg8::GroupOrder S; S.init(false, 4, 4, 4, 4, grp, wg16);
                pg8::EpiStore E{NT, 1024, nullptr, nullptr, 2, (long)1024 * 1024};
                pg8::gemm_phase(lds, g, S, E);
            }
            GROUP_BAR();
            {
                pg8::Gemm g = pg8::mk_gemm(XB, MT, 1024, 1024, 1024, 256, 4, 0, 256 * 1024, (long)1024 * 1024, 4);
                pg8::GroupOrder S; S.init(true, 16, 4, 4, 4, grp, wg16);
                pg8::EpiSoftmax E{P, 1024, (LAS float*)(lds + SMX_OFF), RSTD};
                pg8::gemm_phase(lds, g, S, E);
            }
            GROUP_BAR();
            FUSED_OUT((P, NT, 1024, 1024, 1024, 256, 4, 0, 256 * 1024, (long)1024 * 1024, 4), 256, layer * 3 + 1, 0, 0, n_xa_post + layer * DM, nullptr);
            GROUP_BAR();
        }
        {
            bf16_t* ACT = SCR_ROWS(0, DFF);
            {
                pg8::Gemm g = pg8::mk_gemm(XB, WB + WO_FF_IN + (size_t)layer * 5632 * 1024, 1024, 1024, 1024, 256, 22, 0, 256 * 1024, 0, 30);
                pg8::GroupOrder S; S.init(true, 16, 20, 4, 4, grp, wg16); S.tail0 = 20; S.rounds = 22;
                pg8::EpiSwiglu E{ACT, DFF, RSTD};
                pg8::gemm_phase(lds, g, S, E);
            }
            GROUP_BAR();
            FUSED_OUT((ACT, WB + WO_FF_OUT + (size_t)layer * 1024 * 2816, DFF, DFF, DFF, 256, 4, 0, (long)256 * DFF, 0, 30), 256, layer * 3 + 2, 0, 0, n_ffn_post + layer * DM, (layer == DEPTH - 1 ? X : nullptr));
            GROUP_BAR();
        }
    }
}

extern "C" void kernel_launch(void* const* d_in, const int* in_sizes, int n_in, void* d_out, int out_size, void* d_ws, size_t ws_size, hipStream_t stream) {
    static int grid = 0;
    if (grid == 0) {
        if (n_in != 21 || in_sizes[0] != NTOK * DM || out_size != NTOK * DM || ws_size < WS_END) {
            fprintf(stderr, "kernel_launch: unexpected problem (n_in %d, in0 %d, out %d, ws %zu, need %zu); nothing launched\n", n_in, n_in > 0 ? in_sizes[0] : -1, out_size, ws_size, (size_t)WS_END); grid = -1; return; }
        int dev = 0, cus = 0, per_cu = 0;
        if (hipGetDevice(&dev) != hipSuccess || hipDeviceGetAttribute(&cus, hipDeviceAttributeMultiprocessorCount, dev) != hipSuccess) { grid = -1; return; }
        if (hipFuncSetAttribute((const void*)fwd_kernel, hipFuncAttributeMaxDynamicSharedMemorySize, LDS_BYTES) != hipSuccess) { fprintf(stderr, "kernel_launch: hipFuncSetAttribute failed\n"); grid = -1; return; }
        if (hipOccupancyMaxActiveBlocksPerMultiprocessor(&per_cu, (const void*)fwd_kernel, 512, LDS_BYTES) != hipSuccess || per_cu < 1)
            fprintf(stderr, "kernel_launch: note: occupancy query reports %d workgroups per CU\n", per_cu);
        (void)hipGetLastError();
        if (cus != 256) { fprintf(stderr, "kernel_launch: built for 256 CUs (one 256-unit GEMM round per workgroup in the fused post-norm phases), device has %d; nothing launched\n", cus); grid = -1; return; }
        grid = cus;
    }
    if (grid < 0) return;
    if (hipMemsetAsync((char*)d_ws + WS_CTL, 0, CTL_ZERO_BYTES, stream) != hipSuccess) return;
    Args a{};
    for (int i = 0; i < 21; ++i) a.in[i] = (const float*)d_in[i];
    a.out = (float*)d_out; a.ws = (unsigned char*)d_ws;
    hipLaunchKernelGGL(fwd_kernel, dim3(grid), dim3(512), LDS_BYTES, stream, a);
}
```

```cpp
#include <hip/hip_runtime.h>
#include <cstdio>
#include <cstdint>

#define LAS __attribute__((address_space(3)))
#define GAS __attribute__((address_space(1)))
typedef unsigned short bf16_t;
typedef short bf16x8 __attribute__((ext_vector_type(8)));
typedef short bf16x4 __attribute__((ext_vector_type(4)));
typedef float f32x4 __attribute__((ext_vector_type(4)));
typedef float f32x2 __attribute__((ext_vector_type(2)));
typedef float f32x16 __attribute__((ext_vector_type(16)));
typedef unsigned u32x4 __attribute__((ext_vector_type(4)));
typedef unsigned u32x2 __attribute__((ext_vector_type(2)));
typedef __bf16 bf16x2_t __attribute__((ext_vector_type(2)));
#define DI __device__ __forceinline__

constexpr int NB = 16, SEQ = 4096, DM = 1024, NTOK = NB * SEQ, DEPTH = 4, DFF = 2816, MEML = 256, NMEM = NB * MEML;
constexpr int LDT = 4160;
constexpr int LDR = 4104;
constexpr float RMS_EPS = 1e-6f, GN_EPS = 1e-5f, LOG2E = 1.4426950408889634f;

constexpr size_t MiB = 1u << 20;
constexpr size_t WS_CTL = 0, CTL_ZERO_BYTES = 64 * 1024;
constexpr size_t WS_RSTD = 1 * MiB;
constexpr size_t WS_MRSTD = WS_RSTD + 256 * 1024;
constexpr size_t WS_ROPE = 2 * MiB;
constexpr size_t WS_MEMB = 10 * MiB;
constexpr size_t WS_KMEM = 18 * MiB;
constexpr size_t WS_VTMEM = 50 * MiB;
constexpr size_t WS_WB = 82 * MiB;
constexpr size_t WS_XB = 210 * MiB;
constexpr size_t WS_MB = 338 * MiB;
constexpr size_t WS_R = 466 * MiB;
constexpr size_t WS_XCH = WS_R + 520 * MiB;
constexpr size_t WS_SSQ = WS_XCH + 2 * MiB;
constexpr size_t WS_SC = WS_SSQ + 1 * MiB;
constexpr size_t WS_END = WS_SC + 32 * MiB;

constexpr size_t WO_POOL = 0;
constexpr size_t WO_SB_QK = WO_POOL + 2 * 262144;
constexpr size_t WO_SB_V = WO_SB_QK + 2048 * 1024;
constexpr size_t WO_SB_O = WO_SB_V + 1024 * 1024;
constexpr size_t WO_RT_QK = WO_SB_O + 1024 * 1024;
constexpr size_t WO_RT_KV = WO_RT_QK + 2048 * 1024;
constexpr size_t WO_RT_G = WO_RT_KV + 3072 * 1024;
constexpr size_t WO_RT_O = WO_RT_G + 2048 * 1024;
constexpr size_t WO_XA_Q = WO_RT_O + 1024 * 2048;
constexpr size_t WO_XA_K = WO_XA_Q + 4 * 1024 * 1024;
constexpr size_t WO_XA_V = WO_XA_K + 4 * 1024 * 1024;
constexpr size_t WO_XA_O = WO_XA_V + 4 * 1024 * 1024;
constexpr size_t WO_FF_IN = WO_XA_O + 4 * 1024 * 1024;
constexpr size_t WO_FF_OUT = WO_FF_IN + 4 * (size_t)5632 * 1024;
constexpr size_t WO_END = WO_FF_OUT + 4 * (size_t)1024 * 2816;
static_assert(WO_END * 2 <= 128 * MiB, "weights fit");

constexpr int CW_BAR = 4096;
constexpr int CW_GRP = 8192;

constexpr int RING_BYTES = 131072;
constexpr int SMX_OFF = RING_BYTES;
constexpr int MISC_OFF = RING_BYTES + 16384;
constexpr int RT_OFF = 149504;
constexpr int LDS_BYTES = 157696;

DI unsigned cvtpk(float lo, float hi) { f32x2 v = {lo, hi}; bf16x2_t b = __builtin_convertvector(v, bf16x2_t); return __builtin_bit_cast(unsigned, b); }
DI float bf2f(unsigned short b) { return __uint_as_float(((unsigned)b) << 16); }
DI float bflo(unsigned w) { return __uint_as_float(w << 16); }
DI float bfhi(unsigned w) { return __uint_as_float(w & 0xffff0000u); }
DI float xsum16(float v) { const auto r = __builtin_amdgcn_permlane16_swap(__float_as_uint(v), __float_as_uint(v), false, false); return __uint_as_float(r[0]) + __uint_as_float(r[1]); }
DI float xsum32(float v) { const auto r = __builtin_amdgcn_permlane32_swap(__float_as_uint(v), __float_as_uint(v), false, false); return __uint_as_float(r[0]) + __uint_as_float(r[1]); }
DI float xmax16(float v) { const auto r = __builtin_amdgcn_permlane16_swap(__float_as_uint(v), __float_as_uint(v), false, false); return fmaxf(__uint_as_float(r[0]), __uint_as_float(r[1])); }
DI float xmax32(float v) { const auto r = __builtin_amdgcn_permlane32_swap(__float_as_uint(v), __float_as_uint(v), false, false); return fmaxf(__uint_as_float(r[0]), __uint_as_float(r[1])); }
DI float xchg32(float v, int upper) { const auto r = __builtin_amdgcn_permlane32_swap(__float_as_uint(v), __float_as_uint(v), false, false); return __uint_as_float(upper ? r[0] : r[1]); }
DI float rowsum16(float v) {
    v += __uint_as_float(__builtin_amdgcn_update_dpp(0, __float_as_uint(v), 0x128, 0xf, 0xf, false));
    v += __uint_as_float(__builtin_amdgcn_update_dpp(0, __float_as_uint(v), 0x124, 0xf, 0xf, false));
    v += __uint_as_float(__builtin_amdgcn_update_dpp(0, __float_as_uint(v), 0x122, 0xf, 0xf, false));
    v += __uint_as_float(__builtin_amdgcn_update_dpp(0, __float_as_uint(v), 0x121, 0xf, 0xf, false));
    return v; }
DI float wave_sum(float v) { return xsum32(xsum16(rowsum16(v))); }
DI float ex2(float x) { return __builtin_amdgcn_exp2f(x); }
DI float lg2(float x) { return __builtin_amdgcn_logf(x); }
DI float rstd_of(const float* ssq, int row) { const f32x4 p = *(const f32x4*)(ssq + (size_t)row * 4); return __builtin_amdgcn_rsqf(((p[0] + p[1]) + (p[2] + p[3])) * (1.0f / DM) + RMS_EPS); }
DI float rstd_q(const f32x4 p) { return __builtin_amdgcn_rsqf(((p[0] + p[1]) + (p[2] + p[3])) * (1.0f / DM) + RMS_EPS); }
DI float silu(float g) { return g * __builtin_amdgcn_rcpf(1.0f + ex2(-g * LOG2E)); }
#define LDS_WAIT() asm volatile("s_waitcnt lgkmcnt(0)" ::: "memory")
#define VM_WAIT() asm volatile("s_waitcnt vmcnt(0)" ::: "memory")

namespace pg8 {
constexpr int BM = 256, BK = 64, HALF = 128, HTB = HALF * BK * 2, STAGE_BYTES = 8 * HTB, NXCD = 8, WGM = 8;
DI int lds_byte(int r, int c) { const int st = (r >> 4) * 2 + (c >> 5), rr = r & 15, cc = c & 31, ob = rr * 64 + cc * 2; return st * 1024 + (ob ^ (((ob >> 9) & 1) << 5)); }
DI void stage_rc(int b, int& R, int& C) { const int st = b / 1024, sb = b % 1024, swz = sb ^ (((sb >> 9) & 1) << 5); R = (st >> 1) * 16 + swz / 64; C = (st & 1) * 32 + (swz % 64) / 2; }
DI int perm32(int rho) { const int n = rho >> 4, i = rho & 15; return 8 * (i >> 2) + 4 * n + (i & 3); }
struct Unit { int pm, pn; };
struct Gemm { const bf16_t* A; const bf16_t* B; int lda, ldb, K, nM, nN, msh, nsh; long a_ml, a_mh, a_nl, a_nh, b_ml, b_mh, b_nl, b_nh;
    DI const char* aptr(int pm, int pn) const { return (const char*)(A + (size_t)(pm & ((1 << msh) - 1)) * a_ml + (size_t)(pm >> msh) * a_mh + (size_t)(pn & ((1 << nsh) - 1)) * a_nl + (size_t)(pn >> nsh) * a_nh); }
    DI const char* bptr(int pm, int pn) const { return (const char*)(B + (size_t)(pm & ((1 << msh) - 1)) * b_ml + (size_t)(pm >> msh) * b_mh + (size_t)(pn & ((1 << nsh) - 1)) * b_nl + (size_t)(pn >> nsh) * b_nh); } };
DI Gemm mk_gemm(const bf16_t* A, const bf16_t* B, int lda, int ldb, int K, int nM, int nN, long a_pn, long b_pn, long b_z, int zshift) {
    return Gemm{A, B, lda, ldb, K, nM, nN, zshift, 30, 256L * lda, (256L * lda) << zshift, a_pn, 0, 0, b_z, b_pn, 0}; }
struct StaticOrder {
    int nM, nN, nwg, G, c;
    DI void init(int nM_, int nN_, int G_, int c_) { nM = nM_; nN = nN_; nwg = nM * nN; G = G_; c = c_; }
    DI bool next(int i, Unit& u) const {
        const long L = (long)i * G + c; if (L >= nwg) return false;
        int wgid = (int)L; { const int q = nwg / NXCD, r = nwg % NXCD, xcd = wgid % NXCD, off = wgid / NXCD; wgid = (xcd < r ? xcd * (q + 1) : r * (q + 1) + (xcd - r) * q) + off; }
        const int nig = WGM * nN, gid = wgid / nig, fm = gid * WGM, gsz = (nM - fm) < WGM ? (nM - fm) : WGM;
        u.pm = fm + ((wgid % nig) % gsz); u.pn = (wgid % nig) / gsz; return true;
    }
};

template <class Epi, class Sched>
DI void gemm_phase(LAS unsigned char* lds, const Gemm g, const Sched& S, const Epi& E) {
    int tid = threadIdx.x; asm volatile("" : "+v"(tid));
    const int wid = __builtin_amdgcn_readfirstlane(tid >> 6), lane = tid & 63, wr = wid >> 2, wc = wid & 3, fr = lane & 15, fq = lane >> 4;
    const int K = g.K, nt = K / BK;
    unsigned voffA[2], voffB[2];
#pragma unroll
    for (int i = 0; i < 2; ++i) { int R, C; stage_rc(tid * 16 + i * 8192, R, C); const int Rb = (R & ~31) + perm32(R & 31);
        voffA[i] = (unsigned)(R * g.lda + C) * 2u; voffB[i] = (unsigned)(Rb * g.ldb + C) * 2u; }
    const size_t kstep = (size_t)(BK * 2);
    const size_t hstepA = (size_t)HALF * g.lda * 2, hstepB = (size_t)HALF * g.ldb * 2;
    const unsigned ldsw = (unsigned)wid * 1024u;
    const int aoff = lds_byte(wr * 64 + fr, fq * 8), boff = lds_byte(wc * 32 + fr, fq * 8);
#define PG8_SA(b, h) (((b) * 2 + (h)) * HTB)
#define PG8_SB(b, h) ((4 + (b) * 2 + (h)) * HTB)
#define PG8_STAGE(bufoff, gbase, voff) do { _Pragma("unroll") for (int _i = 0; _i < 2; ++_i) \
        __builtin_amdgcn_global_load_lds((const unsigned*)((const char*)(gbase) + (voff)[_i]), (LAS unsigned*)(lds + (bufoff) + ldsw + _i * 8192), 16, 0, 0); } while (0)
#define PG8_LDA(dst, b, h) do { _Pragma("unroll") for (int m = 0; m < 4; ++m) _Pragma("unroll") for (int k = 0; k < 2; ++k) dst[m][k] = *(const LAS bf16x8*)(lds + PG8_SA(b, h) + aoff + m * 2048 + k * 1024); } while (0)
#define PG8_LDB(dst, b, h) do { _Pragma("unroll") for (int n = 0; n < 2; ++n) _Pragma("unroll") for (int k = 0; k < 2; ++k) dst[n][k] = *(const LAS bf16x8*)(lds + PG8_SB(b, h) + boff + n * 2048 + k * 1024); } while (0)
#define PG8_MMA(ai, bj, At, Bt) do { __builtin_amdgcn_s_setprio(1); _Pragma("unroll") for (int m = 0; m < 4; ++m) _Pragma("unroll") for (int n = 0; n < 2; ++n) _Pragma("unroll") for (int k = 0; k < 2; ++k) \
        acc[ai][bj][m][n] = __builtin_amdgcn_mfma_f32_16x16x32_bf16(Bt[n][k], At[m][k], acc[ai][bj][m][n], 0, 0, 0); __builtin_amdgcn_s_setprio(0); } while (0)
#define PG8_WAIT_V(n) asm volatile("s_waitcnt vmcnt(" #n ")" ::: "memory")
#define PG8_WAIT_L(n) asm volatile("s_waitcnt lgkmcnt(" #n ")" ::: "memory")
#define PG8_BAR __builtin_amdgcn_s_barrier()
#define PG8_SCHED __builtin_amdgcn_sched_barrier(0)
    Unit cur, nxt; int ui = 0;
    if (!S.next(0, cur)) return;
    f32x4 acc[2][2][4][2];
#pragma unroll
    for (int a = 0; a < 2; ++a)
#pragma unroll
        for (int b = 0; b < 2; ++b)
#pragma unroll
            for (int m = 0; m < 4; ++m)
#pragma unroll
                for (int n = 0; n < 2; ++n) acc[a][b][m][n] = (f32x4){0.f, 0.f, 0.f, 0.f};
    bf16x8 At[4][2], B0[2][2], B1[2][2];
    const char* cA = g.aptr(cur.pm, cur.pn);
    const char* cB = g.bptr(cur.pm, cur.pn);
    LAS float* rtab = (LAS float*)(lds + RT_OFF);
    const float* rsp = nullptr;
    if constexpr (Epi::ROWSTAT) { rsp = E.rs ? E.rs : (const float*)g.A;
        __builtin_amdgcn_global_load_lds((const unsigned*)(rsp + (size_t)(cur.pm * BM + (wid & 3) * 64 + lane) * 4), (LAS unsigned*)(rtab + (wid & 3) * 256), 16, 0, 0); }
    PG8_STAGE(PG8_SB(0, 0), cB, voffB); PG8_STAGE(PG8_SB(0, 1), cB + hstepB, voffB); PG8_STAGE(PG8_SA(0, 0), cA, voffA); PG8_STAGE(PG8_SA(0, 1), cA + hstepA, voffA);
    if (wr == 1) PG8_BAR;
    PG8_WAIT_V(2); PG8_BAR;
    PG8_STAGE(PG8_SB(1, 0), cB + kstep, voffB); PG8_STAGE(PG8_SA(1, 0), cA + kstep, voffA); PG8_STAGE(PG8_SB(1, 1), cB + hstepB + kstep, voffB);
    PG8_WAIT_V(6); PG8_BAR;
    for (;;) {
        const bool has_next = S.next(ui + 1, nxt);
        const char* nA = has_next ? g.aptr(nxt.pm, nxt.pn) : cA;
        const char* nB = has_next ? g.bptr(nxt.pm, nxt.pn) : cB;
        for (int t = 0; t < nt; t += 2) {
            const bool last = (t == nt - 2);
            const char* a1 = cA + (size_t)(t + 1) * kstep;
            const char* a2 = last ? nA : cA + (size_t)(t + 2) * kstep; const char* b2 = last ? nB : cB + (size_t)(t + 2) * kstep;
            const char* a3 = a2 + kstep; const char* b3 = b2 + kstep;
            PG8_LDB(B0, 0, 0); PG8_LDB(B1, 0, 1); PG8_SCHED; PG8_LDA(At, 0, 0); PG8_STAGE(PG8_SA(1, 1), a1 + hstepA, voffA);
            PG8_WAIT_V(8); PG8_WAIT_L(0); PG8_BAR; PG8_MMA(0, 0, At, B0); PG8_MMA(0, 1, At, B1); PG8_BAR; PG8_SCHED;
            PG8_LDA(At, 0, 1); PG8_STAGE(PG8_SB(0, 0), b2, voffB); PG8_STAGE(PG8_SB(0, 1), b2 + hstepB, voffB); PG8_STAGE(PG8_SA(0, 0), a2, voffA);
            PG8_WAIT_V(8); PG8_WAIT_L(0); PG8_BAR; PG8_MMA(1, 0, At, B0); PG8_MMA(1, 1, At, B1); PG8_BAR; PG8_SCHED;
            PG8_LDB(B0, 1, 0); PG8_LDB(B1, 1, 1); PG8_SCHED; PG8_LDA(At, 1, 0); PG8_STAGE(PG8_SA(0, 1), a2 + hstepA, voffA);
            PG8_WAIT_V(8); PG8_WAIT_L(0); PG8_BAR; PG8_MMA(0, 0, At, B0); PG8_MMA(0, 1, At, B1); PG8_BAR; PG8_SCHED;
            PG8_LDA(At, 1, 1); PG8_STAGE(PG8_SB(1, 0), b3, voffB); PG8_STAGE(PG8_SB(1, 1), b3 + hstepB, voffB); PG8_STAGE(PG8_SA(1, 0), a3, voffA);
            PG8_WAIT_V(8); PG8_WAIT_L(0); PG8_BAR; PG8_MMA(1, 0, At, B0); PG8_MMA(1, 1, At, B1); PG8_BAR; PG8_SCHED;
        }
        if (wr == 0) PG8_BAR;
        if constexpr (!Epi::AFTER_DRAIN) { int fr_ = fr, fq_ = fq; asm volatile("" : "+v"(fr_), "+v"(fq_));
          if constexpr (Epi::ROWSTAT) __builtin_amdgcn_global_load_lds((const unsigned*)(rsp + (size_t)((has_next ? nxt.pm : cur.pm) * BM + (wid & 3) * 64 + lane) * 4), (LAS unsigned*)(rtab + ((ui + 1) & 1) * 1024 + (wid & 3) * 256), 16, 0, 0);
          E(acc, cur, wr, wc, fr_, fq_, rtab + (ui & 1) * 1024); }
        if (!has_next) break;
#pragma unroll
        for (int a = 0; a < 2; ++a)
#pragma unroll
            for (int b = 0; b < 2; ++b)
#pragma unroll
                for (int m = 0; m < 4; ++m)
#pragma unroll
                    for (int n = 0; n < 2; ++n) acc[a][b][m][n] = (f32x4){0.f, 0.f, 0.f, 0.f};
        cur = nxt; cA = nA; cB = nB; ++ui;
        if (wr == 1) PG8_BAR;
    }
    PG8_WAIT_V(0);
    PG8_BAR;
    if constexpr (Epi::AFTER_DRAIN) { int fr_ = fr, fq_ = fq; asm volatile("" : "+v"(fr_), "+v"(fq_)); E.fused(acc, cur, wr, wc, fr_, fq_, lds, wid, lane); }
#undef PG8_SA
#undef PG8_SB
#undef PG8_STAGE
#undef PG8_LDA
#undef PG8_LDB
#undef PG8_MMA
#undef PG8_WAIT_V
#undef PG8_WAIT_L
#undef PG8_BAR
#undef PG8_SCHED
}

struct RoundOrder : StaticOrder { int round; DI bool next(int i, Unit& u) const { return i == 0 ? StaticOrder::next(round, u) : false; } };
struct GroupOrder {
    int grp, w, TT, PB, TB, ntb, rounds; bool tokM; int tail0 = 1 << 30;
    DI void init(bool tokM_, int TT_, int nOther, int PB_, int TB_, int grp_, int w_) { tokM = tokM_; TT = TT_; PB = PB_; TB = TB_; ntb = nOther / TB_; rounds = TT_ * nOther / 16; grp = grp_; w = w_; }
    DI bool next(int i, Unit& u) const {
        if (i >= rounds) return false;
        if (i >= tail0) { const int bt8 = TT * grp + (i - tail0) * 8 + (w & 7), ot2 = ntb * TB + (w >> 3); if (tokM) { u.pm = bt8; u.pn = ot2; } else { u.pm = ot2; u.pn = bt8; } return true; }
        const int pb = i / ntb, tb = i - pb * ntb, bt = TT * grp + pb * PB + (w % PB), ot = tb * TB + (w / PB);
        if (tokM) { u.pm = bt; u.pn = ot; } else { u.pm = ot; u.pn = bt; }
        return true; }
};
typedef f32x4 Acc[2][2][4][2];

struct EpiStore {
    static constexpr bool AFTER_DRAIN = false; static constexpr bool ROWSTAT = true;
    bf16_t* O; long ldc; const float* rs; const float* cs; int csh; long cbs;
    DI void operator()(const Acc& acc, const Unit& u, int wr, int wc, int fr, int fq, const LAS float* rt) const {
        const int row0 = u.pm * BM + wr * 64 + fr;
        const long cbase = (long)(u.pn >> csh) * cbs + (long)(u.pn & ((1 << csh) - 1)) * 256 + wc * 32 + 8 * fq;
        float pr[2][4];
        if (rs) {
#pragma unroll
            for (int ai = 0; ai < 2; ++ai)
#pragma unroll
                for (int m = 0; m < 4; ++m) pr[ai][m] = rstd_q(*(const LAS f32x4*)(rt + 4 * (ai * HALF + wr * 64 + m * 16 + fr))); }
        float csv[2][8];
#pragma unroll
        for (int bj = 0; bj < 2; ++bj) {
            if (cs) {
#pragma unroll
                for (int k = 0; k < 8; ++k) csv[bj][k] = rstd_of(cs, u.pn * BM + bj * HALF + wc * 32 + 8 * fq + k); }
            else {
#pragma unroll
                for (int k = 0; k < 8; ++k) csv[bj][k] = 1.f; }
        }
        asm volatile("" ::: "memory");
#pragma unroll
        for (int ai = 0; ai < 2; ++ai)
#pragma unroll
            for (int m = 0; m < 4; ++m) { const int row = row0 + ai * HALF + m * 16; const float r = rs ? pr[ai][m] : 1.f;
                bf16_t* rowp = O + (size_t)row * ldc + cbase;
#pragma unroll
                for (int bj = 0; bj < 2; ++bj) { const f32x4 v0 = acc[ai][bj][m][0], v1 = acc[ai][bj][m][1];
                    u32x4 w; w.x = cvtpk(v0[0] * r * csv[bj][0], v0[1] * r * csv[bj][1]); w.y = cvtpk(v0[2] * r * csv[bj][2], v0[3] * r * csv[bj][3]);
                    w.z = cvtpk(v1[0] * r * csv[bj][4], v1[1] * r * csv[bj][5]); w.w = cvtpk(v1[2] * r * csv[bj][6], v1[3] * r * csv[bj][7]);
                    *(u32x4*)(rowp + bj * HALF) = w; } }
    }
};
struct EpiSwiglu {
    static constexpr bool AFTER_DRAIN = false; static constexpr bool ROWSTAT = true;
    bf16_t* O; long ldc; const float* rs;
    DI void operator()(const Acc& acc, const Unit& u, int wr, int wc, int fr, int fq, const LAS float* rt) const {
        const int row0 = u.pm * BM + wr * 64 + fr; const int col = u.pn * 128 + wc * 32 + 8 * fq;
        float pr[2][4];
#pragma unroll
        for (int ai = 0; ai < 2; ++ai)
#pragma unroll
            for (int m = 0; m < 4; ++m) pr[ai][m] = rstd_q(*(const LAS f32x4*)(rt + 4 * (ai * HALF + wr * 64 + m * 16 + fr)));
        asm volatile("" ::: "memory");
#pragma unroll
        for (int ai = 0; ai < 2; ++ai)
#pragma unroll
            for (int m = 0; m < 4; ++m) { const int row = row0 + ai * HALF + m * 16; const float r = pr[ai][m]; const float rc = r * -LOG2E, r2i = __builtin_amdgcn_rcpf(r * r);
                const f32x4 g0 = acc[ai][0][m][0], g1 = acc[ai][0][m][1], u0 = acc[ai][1][m][0], u1 = acc[ai][1][m][1];
                const f32x4 x0 = g0 * rc, x1 = g1 * rc, p0 = g0 * u0, p1 = g1 * u1;
                f32x4 e0, e1;
#pragma unroll
                for (int i = 0; i < 4; ++i) { e0[i] = ex2(x0[i]); e1[i] = ex2(x1[i]); }
                const f32x4 d0 = e0 * r2i + r2i, d1 = e1 * r2i + r2i;
                f32x4 q0, q1;
#pragma unroll
                for (int i = 0; i < 4; ++i) { q0[i] = __builtin_amdgcn_rcpf(d0[i]); q1[i] = __builtin_amdgcn_rcpf(d1[i]); }
                const f32x4 o0 = p0 * q0, o1 = p1 * q1;
                u32x4 w; w.x = cvtpk(o0[0], o0[1]); w.y = cvtpk(o0[2], o0[3]); w.z = cvtpk(o1[0], o1[1]); w.w = cvtpk(o1[2], o1[3]);
                *(u32x4*)(O + (size_t)row * ldc + col) = w; }
    }
};
struct EpiSoftmax {
    static constexpr bool AFTER_DRAIN = false; static constexpr bool ROWSTAT = true;
    bf16_t* O; long ldc; LAS float* tab; const float* rs;
    DI void operator()(Acc& acc, const Unit& u, int wr, int wc, int fr, int fq, const LAS float* rt) const {
        float mw[2][4];
        float pr[2][4];
        if (rs) {
#pragma unroll
            for (int ai = 0; ai < 2; ++ai)
#pragma unroll
                for (int m = 0; m < 4; ++m) pr[ai][m] = rstd_q(*(const LAS f32x4*)(rt + 4 * (ai * HALF + wr * 64 + m * 16 + fr))); }
        asm volatile("" ::: "memory");
#pragma unroll
        for (int ai = 0; ai < 2; ++ai)
#pragma unroll
            for (int m = 0; m < 4; ++m) {
                const float rsc = rs ? pr[ai][m] : 1.f;
                float mx = -INFINITY;
#pragma unroll
                for (int bj = 0; bj < 2; ++bj)
#pragma unroll
                    for (int n = 0; n < 2; ++n) { const f32x4 v = acc[ai][bj][m][n]; mx = fmaxf(fmaxf(mx, fmaxf(v[0], v[1])), fmaxf(v[2], v[3])); }
                mx = xmax32(xmax16(mx)) * rsc;
                const float nm = -mx;
                float s = 0.f;
#pragma unroll
                for (int bj = 0; bj < 2; ++bj)
#pragma unroll
                    for (int n = 0; n < 2; ++n)
#pragma unroll
                        for (int i = 0; i < 4; ++i) { const float p = ex2(__builtin_fmaf(acc[ai][bj][m][n][i], rsc, nm)); acc[ai][bj][m][n][i] = p; s += p; }
                s = xsum32(xsum16(s));
                mw[ai][m] = mx;
                const int r = ai * HALF + wr * 64 + m * 16 + fr;
                if (fq == 0) { tab[(r * 4 + wc) * 2] = mx; tab[(r * 4 + wc) * 2 + 1] = s; }
            }
        LDS_WAIT(); __builtin_amdgcn_s_barrier(); asm volatile("" ::: "memory");
        const int row0 = u.pm * BM + wr * 64 + fr; const int col = u.pn * BM + wc * 32 + 8 * fq;
#pragma unroll
        for (int ai = 0; ai < 2; ++ai)
#pragma unroll
            for (int m = 0; m < 4; ++m) {
                const int r = ai * HALF + wr * 64 + m * 16 + fr;
                const f32x4 t0 = *(const LAS f32x4*)(tab + r * 8), t1 = *(const LAS f32x4*)(tab + r * 8 + 4);
                const float M = fmaxf(fmaxf(t0[0], t0[2]), fmaxf(t1[0], t1[2]));
                const float L = t0[1] * ex2(t0[0] - M) + t0[3] * ex2(t0[2] - M) + t1[1] * ex2(t1[0] - M) + t1[3] * ex2(t1[2] - M);
                const float f = ex2(mw[ai][m] - M) * __builtin_amdgcn_rcpf(L);
                bf16_t* rowp = O + (size_t)(row0 + ai * HALF + m * 16) * ldc + col;
#pragma unroll
                for (int bj = 0; bj < 2; ++bj) { const f32x4 v0 = acc[ai][bj][m][0] * f, v1 = acc[ai][bj][m][1] * f;
                    u32x4 w; w.x = cvtpk(v0[0], v0[1]); w.y = cvtpk(v0[2], v0[3]); w.z = cvtpk(v1[0], v1[1]); w.w = cvtpk(v1[2], v1[3]);
                    *(u32x4*)(rowp + bj * HALF) = w; }
            }
    }
};
struct EpiRetQK {
    static constexpr bool AFTER_DRAIN = false; static constexpr bool ROWSTAT = true;
    bf16_t* O; long ldc; const float* rs; const float* cosN; const float* sinN;
    DI void operator()(const Acc& acc, const Unit& u, int wr, int wc, int fr, int fq, const LAS float* rt) const {
        const int row0 = u.pm * BM + wr * 64 + fr; const int d0 = wc * 32 + 8 * fq, dt0 = wc * 32 + 4 * fq;
        const float lg = lg2(1.0f - ex2(-5.0f - (float)(u.pn & 3))) * (u.pn < 4 ? 1.f : -1.f);
        float pq[2]; f32x4 cc[2][2], ss[2][2];
#define RQK_LOAD(slot, ai_, m_) do { const int row_ = row0 + (ai_) * HALF + (m_) * 16; const int t_ = row_ & (SEQ - 1); pq[slot] = rstd_q(*(const LAS f32x4*)(rt + 4 * ((ai_) * HALF + wr * 64 + (m_) * 16 + fr))); \
            cc[slot][0] = *(const f32x4*)(cosN + (size_t)t_ * 128 + dt0); cc[slot][1] = *(const f32x4*)(cosN + (size_t)t_ * 128 + dt0 + 16); \
            ss[slot][0] = *(const f32x4*)(sinN + (size_t)t_ * 128 + dt0); ss[slot][1] = *(const f32x4*)(sinN + (size_t)t_ * 128 + dt0 + 16); } while (0)
        RQK_LOAD(0, 0, 0);
#pragma unroll
        for (int ai = 0; ai < 2; ++ai)
#pragma unroll
            for (int m = 0; m < 4; ++m) { const int g = ai * 4 + m, sl = g & 1; const int row = row0 + ai * HALF + m * 16; const int t = row & (SEQ - 1);
                if (g < 7) RQK_LOAD(sl ^ 1, (g + 1) >> 2, (g + 1) & 3);
                asm volatile("" ::: "memory");
                const float r = pq[sl] * ex2((float)(t & 63) * lg);
                bf16_t* rowp = O + (size_t)row * ldc + u.pn * BM + d0;
                float o1[8], o2[8];
#pragma unroll
                for (int n = 0; n < 2; ++n) { const f32x4 c = cc[sl][n], sn = ss[sl][n];
#pragma unroll
                    for (int i = 0; i < 4; ++i) { const float x1 = acc[ai][0][m][n][i] * r, x2 = acc[ai][1][m][n][i] * r; o1[4 * n + i] = x1 * c[i] - x2 * sn[i]; o2[4 * n + i] = x1 * sn[i] + x2 * c[i]; } }
                const bool hsw = (u.pn >= 4) && ((t & 8) != 0);
                u32x4 w; w.x = cvtpk(o1[0], o1[1]); w.y = cvtpk(o1[2], o1[3]); w.z = cvtpk(o1[4], o1[5]); w.w = cvtpk(o1[6], o1[7]); if (hsw) w = (u32x4){w.z, w.w, w.x, w.y}; *(u32x4*)(rowp) = w;
                w.x = cvtpk(o2[0], o2[1]); w.y = cvtpk(o2[2], o2[3]); w.z = cvtpk(o2[4], o2[5]); w.w = cvtpk(o2[6], o2[7]); if (hsw) w = (u32x4){w.z, w.w, w.x, w.y}; *(u32x4*)(rowp + HALF) = w;
                asm volatile("" ::: "memory"); }
#undef RQK_LOAD
    }
};
struct EpiRetKVT {
    static constexpr bool AFTER_DRAIN = false; static constexpr bool ROWSTAT = false;
    bf16_t* O; const float* cs;
    DI void operator()(const Acc& acc, const Unit& u, int wr, int wc, int fr, int fq, const LAS float* rt) const {
        const int rl0 = wr * 64 + fr;
        const int tcol = (u.pn & 15) * 256 + wc * 32 + 8 * fq;
        bf16_t* base = O + (size_t)(u.pn >> 4) * 2048 * LDR + (size_t)(u.pm * BM) * LDR + tcol;
        float csv[2][8];
#pragma unroll
        for (int bj = 0; bj < 2; ++bj)
#pragma unroll
            for (int k = 0; k < 8; ++k) csv[bj][k] = rstd_of(cs, u.pn * BM + bj * HALF + wc * 32 + 8 * fq + k);
#pragma unroll
        for (int ai = 0; ai < 2; ++ai)
#pragma unroll
            for (int m = 0; m < 4; ++m) { bf16_t* rowp = base + (size_t)(rl0 + ai * HALF + m * 16) * LDR;
#pragma unroll
                for (int bj = 0; bj < 2; ++bj) { const f32x4 v0 = acc[ai][bj][m][0], v1 = acc[ai][bj][m][1];
                    u32x4 w; w.x = cvtpk(v0[0] * csv[bj][0], v0[1] * csv[bj][1]); w.y = cvtpk(v0[2] * csv[bj][2], v0[3] * csv[bj][3]);
                    w.z = cvtpk(v1[0] * csv[bj][4], v1[1] * csv[bj][5]); w.w = cvtpk(v1[2] * csv[bj][6], v1[3] * csv[bj][7]);
                    *(u32x4*)(rowp + bj * HALF) = w; } }
    }
};
struct EpiRetGate {
    static constexpr bool AFTER_DRAIN = false; static constexpr bool ROWSTAT = true;
    bf16_t* Y; long ldc; const float* rs; const float* gns; const float* gain;
    DI void operator()(const Acc& acc, const Unit& u, int wr, int wc, int fr, int fq, const LAS float* rt) const {
        const int row0 = u.pm * BM + wr * 64 + fr; const int col = u.pn * BM + wc * 32 + 8 * fq;
        float gv[2][8];
#pragma unroll
        for (int bj = 0; bj < 2; ++bj) { const f32x4 a = *(const f32x4*)(gain + col + bj * HALF), b = *(const f32x4*)(gain + col + bj * HALF + 4);
            gv[bj][0] = a[0]; gv[bj][1] = a[1]; gv[bj][2] = a[2]; gv[bj][3] = a[3]; gv[bj][4] = b[0]; gv[bj][5] = b[1]; gv[bj][6] = b[2]; gv[bj][7] = b[3]; }
        float pq[2]; f32x4 g0[2], g1[2]; u32x4 on[2][2];
#define RG_LOAD(slot, ai_, m_) do { const int row_ = row0 + (ai_) * HALF + (m_) * 16; pq[slot] = rstd_q(*(const LAS f32x4*)(rt + 4 * ((ai_) * HALF + wr * 64 + (m_) * 16 + fr))); \
            g0[slot] = *(const f32x4*)(gns + (size_t)row_ * 32 + (u.pn >> 1) * 8); g1[slot] = *(const f32x4*)(gns + (size_t)row_ * 32 + (u.pn >> 1) * 8 + 4); \
            on[slot][0] = *(const u32x4*)(Y + (size_t)row_ * ldc + col); on[slot][1] = *(const u32x4*)(Y + (size_t)row_ * ldc + col + HALF); } while (0)
        RG_LOAD(0, 0, 0);
#pragma unroll
        for (int ai = 0; ai < 2; ++ai)
#pragma unroll
            for (int m = 0; m < 4; ++m) { const int g = ai * 4 + m, sl = g & 1; const int row = row0 + ai * HALF + m * 16;
                if (g < 7) RG_LOAD(sl ^ 1, (g + 1) >> 2, (g + 1) & 3);
                asm volatile("" ::: "memory");
                const float r = pq[sl]; const f32x4 p0 = g0[sl], p1 = g1[sl];
                const float mu = ((p0[0] + p0[2]) + (p1[0] + p1[2])) * (1.0f / 512.0f), ex2v = ((p0[1] + p0[3]) + (p1[1] + p1[3])) * (1.0f / 512.0f);
                const float gr = __builtin_amdgcn_rsqf(fmaxf(ex2v - mu * mu, 0.f) + GN_EPS);
                bf16_t* rowp = Y + (size_t)row * ldc + col;
#pragma unroll
                for (int bj = 0; bj < 2; ++bj) { const u32x4 onv = on[sl][bj]; const f32x4 v0 = acc[ai][bj][m][0], v1 = acc[ai][bj][m][1];
                    u32x4 w;
                    w.x = cvtpk(silu(v0[0] * r) * (bflo(onv.x) - mu) * gr * gv[bj][0], silu(v0[1] * r) * (bfhi(onv.x) - mu) * gr * gv[bj][1]); w.y = cvtpk(silu(v0[2] * r) * (bflo(onv.y) - mu) * gr * gv[bj][2], silu(v0[3] * r) * (bfhi(onv.y) - mu) * gr * gv[bj][3]);
                    w.z = cvtpk(silu(v1[0] * r) * (bflo(onv.z) - mu) * gr * gv[bj][4], silu(v1[1] * r) * (bfhi(onv.z) - mu) * gr * gv[bj][5]); w.w = cvtpk(silu(v1[2] * r) * (bflo(onv.w) - mu) * gr * gv[bj][6], silu(v1[3] * r) * (bfhi(onv.w) - mu) * gr * gv[bj][7]);
                    *(u32x4*)(rowp + bj * HALF) = w; }
                asm volatile("" ::: "memory"); }
#undef RG_LOAD
    }
};
struct EpiNormRes {
    static constexpr bool AFTER_DRAIN = false; static constexpr bool ROWSTAT = false;
    const bf16_t* xin; bf16_t* xout; float* out32; float* ssq; const float* gpost; unsigned long long* xch; unsigned epoch; LAS unsigned char* tab;
    DI void operator()(Acc& acc, const Unit& u, int wr, int wc, int fr, int fq, const LAS float* rt) const {
        (void)rt;
        const int wid = wr * 4 + wc, lane = fq * 16 + fr;
        LAS float* P = (LAS float*)tab; LAS float* Sg = (LAS float*)(tab + 4096); LAS float* P2 = (LAS float*)(tab + 5120);
        const int col0 = u.pn * BM + wc * 32 + 8 * fq;
        u32x4 xp0[4][2], xp1[4][2];
#pragma unroll
        for (int m = 0; m < 4; ++m)
#pragma unroll
            for (int bj = 0; bj < 2; ++bj) xp0[m][bj] = *(const u32x4*)(xin + (size_t)(u.pm * BM + wr * 64 + m * 16 + fr) * DM + col0 + bj * HALF);
        float gv[2][8];
#pragma unroll
        for (int bj = 0; bj < 2; ++bj) { const f32x4 a = *(const f32x4*)(gpost + col0 + bj * HALF), b = *(const f32x4*)(gpost + col0 + bj * HALF + 4);
            gv[bj][0] = a[0]; gv[bj][1] = a[1]; gv[bj][2] = a[2]; gv[bj][3] = a[3]; gv[bj][4] = b[0]; gv[bj][5] = b[1]; gv[bj][6] = b[2]; gv[bj][7] = b[3]; }
        u32x2 pk[2][4][2];
#pragma unroll
        for (int ai = 1; ai >= 0; --ai) {
#pragma unroll
            for (int m = 0; m < 4; ++m) { float q = 0.f;
#pragma unroll
                for (int bj = 0; bj < 2; ++bj)
#pragma unroll
                    for (int n = 0; n < 2; ++n) { const f32x4 v = acc[ai][bj][m][n]; q += (v[0] * v[0] + v[1] * v[1]) + (v[2] * v[2] + v[3] * v[3]);
                        if (ai == 1) { pk[bj][m][n].x = cvtpk(v[0], v[1]); pk[bj][m][n].y = cvtpk(v[2], v[3]); } }
                q = xsum32(xsum16(q));
                if (fq == 0) P[(ai * HALF + wr * 64 + m * 16 + fr) * 4 + wc] = q; }
            if (ai == 1) { asm volatile("" ::: "memory");
#pragma unroll
                for (int m = 0; m < 4; ++m)
#pragma unroll
                    for (int bj = 0; bj < 2; ++bj) xp1[m][bj] = *(const u32x4*)(xin + (size_t)(u.pm * BM + HALF + wr * 64 + m * 16 + fr) * DM + col0 + bj * HALF);
                asm volatile("" ::: "memory"); }
        }
        LDS_WAIT(); __builtin_amdgcn_s_barrier(); asm volatile("" ::: "memory");
        const int row = wid * 32 + (lane & 31);
        if (lane < 32) { const f32x4 p = *(const LAS f32x4*)(P + row * 4); const float t = (p[0] + p[1]) + (p[2] + p[3]);
            unsigned long long* sl = xch + (size_t)(u.pm * BM + row) * 4;
            __hip_atomic_store(sl + u.pn, ((unsigned long long)epoch << 32) | __float_as_uint(t), __ATOMIC_RELAXED, __HIP_MEMORY_SCOPE_AGENT);
            float tot = 0.f; unsigned sp = 0;
            for (;;) { bool ok = true; tot = 0.f;
#pragma unroll
                for (int k = 0; k < 4; ++k) { const unsigned long long g = __hip_atomic_load(sl + k, __ATOMIC_RELAXED, __HIP_MEMORY_SCOPE_AGENT); ok &= ((unsigned)(g >> 32) == epoch); tot += __uint_as_float((unsigned)g); }
                if (ok || ++sp > (1u << 20)) break;
                __builtin_amdgcn_s_sleep(1); }
            Sg[row] = __builtin_amdgcn_rsqf(tot * (1.0f / DM) + RMS_EPS); }
        LDS_WAIT(); __builtin_amdgcn_s_barrier(); asm volatile("" ::: "memory");
        __builtin_amdgcn_s_waitcnt(0x0F70);
#pragma unroll
        for (int ai = 0; ai < 2; ++ai)
#pragma unroll
            for (int m = 0; m < 4; ++m) { const int r = ai * HALF + wr * 64 + m * 16 + fr; const float rm = Sg[r]; const size_t off = (size_t)(u.pm * BM + r) * DM + col0; float q = 0.f;
#pragma unroll
                for (int bj = 0; bj < 2; ++bj) { const u32x4 xv = ai ? xp1[m][bj] : xp0[m][bj];
                    f32x4 v0, v1;
                    if (ai == 0) { v0 = acc[0][bj][m][0]; v1 = acc[0][bj][m][1]; }
                    else { const u32x2 a = pk[bj][m][0], b = pk[bj][m][1]; v0 = (f32x4){bflo(a.x), bfhi(a.x), bflo(a.y), bfhi(a.y)}; v1 = (f32x4){bflo(b.x), bfhi(b.x), bflo(b.y), bfhi(b.y)}; }
                    float o[8];
                    o[0] = bflo(xv.x) + v0[0] * rm * gv[bj][0]; o[1] = bfhi(xv.x) + v0[1] * rm * gv[bj][1]; o[2] = bflo(xv.y) + v0[2] * rm * gv[bj][2]; o[3] = bfhi(xv.y) + v0[3] * rm * gv[bj][3];
                    o[4] = bflo(xv.z) + v1[0] * rm * gv[bj][4]; o[5] = bfhi(xv.z) + v1[1] * rm * gv[bj][5]; o[6] = bflo(xv.w) + v1[2] * rm * gv[bj][6]; o[7] = bfhi(xv.w) + v1[3] * rm * gv[bj][7];
                    u32x4 w; w.x = cvtpk(o[0], o[1]); w.y = cvtpk(o[2], o[3]); w.z = cvtpk(o[4], o[5]); w.w = cvtpk(o[6], o[7]);
                    *(u32x4*)(xout + off + bj * HALF) = w;
                    if (out32) { *(f32x4*)(out32 + off + bj * HALF) = (f32x4){o[0], o[1], o[2], o[3]}; *(f32x4*)(out32 + off + bj * HALF + 4) = (f32x4){o[4], o[5], o[6], o[7]}; }
                    const float r0 = bflo(w.x), r1 = bfhi(w.x), r2 = bflo(w.y), r3 = bfhi(w.y), r4 = bflo(w.z), r5 = bfhi(w.z), r6 = bflo(w.w), r7 = bfhi(w.w);
                    q += ((r0 * r0 + r1 * r1) + (r2 * r2 + r3 * r3)) + ((r4 * r4 + r5 * r5) + (r6 * r6 + r7 * r7)); }
                q = xsum32(xsum16(q));
                if (fq == 0) P2[r * 4 + wc] = q;
                asm volatile("" ::: "memory"); }
        LDS_WAIT(); __builtin_amdgcn_s_barrier(); asm volatile("" ::: "memory");
        if (lane < 32) { const f32x4 p = *(const LAS f32x4*)(P2 + row * 4); ssq[(size_t)(u.pm * BM + row) * 4 + u.pn] = (p[0] + p[1]) + (p[2] + p[3]); }
    }
};
}

#define XB_TMO      128
#define XB_XCNT(j)  (256  + 64 * (j))
#define XB_XSUB(j)  (1280 + 64 * (j))
#define XB_XGEN(j)  (2304 + 64 * (j))
#define XB_TOP      3328
#define XB_TOPGEN   3392
#define XCD_BAR_WORDS 3456
#define XB_SPIN_CAP (1u << 22)
DI unsigned xb_ld(unsigned* p)              { return __hip_atomic_load(p, __ATOMIC_RELAXED, __HIP_MEMORY_SCOPE_AGENT); }
DI unsigned xb_add(unsigned* p, unsigned v) { return __hip_atomic_fetch_add(p, v, __ATOMIC_RELAXED, __HIP_MEMORY_SCOPE_AGENT); }
DI unsigned xb_xcc_id() { return (unsigned)__builtin_amdgcn_s_getreg((3 << 11) | 20) & 0xFu; }
#define XB_SPIN(cond, bar) do { unsigned _sp = 0; while (cond) { __builtin_amdgcn_s_sleep(1); \
    if ((++_sp & 255u) == 0u) { if (xb_ld(&(bar)[XB_TMO])) break; if (_sp > XB_SPIN_CAP) { atomicAdd(&(bar)[XB_TMO], 1u); break; } } } } while (0)
struct XcdBarrier { unsigned* bar; unsigned x; volatile LAS unsigned* st; };
DI XcdBarrier xcd_barrier_post(unsigned* bar, volatile LAS unsigned* st) {
    XcdBarrier b; b.bar = bar; b.x = xb_xcc_id(); b.st = st;
    if (threadIdx.x == 0) (void)xb_add(&bar[XB_XCNT(b.x)], 1u);
    return b;
}
DI void xcd_barrier_complete(unsigned* bar, unsigned x, unsigned& nloc, unsigned& nx) {
    const unsigned G = gridDim.x * gridDim.y * gridDim.z;
    unsigned sum, cnt, mine, sp = 0u;
    for (;;) {
        sum = 0u; cnt = 0u; mine = 0u;
#pragma unroll
        for (unsigned j = 0; j < 16; ++j) { const unsigned c = xb_ld(&bar[XB_XCNT(j)]); sum += c; cnt += (c > 0u) ? 1u : 0u; mine = (j == x) ? c : mine; }
        if (sum == G) break;
        __builtin_amdgcn_s_sleep(1);
        if ((++sp & 255u) == 0u) { if (xb_ld(&bar[XB_TMO])) break; if (sp > XB_SPIN_CAP) { atomicAdd(&bar[XB_TMO], 1u); break; } }
    }
    nloc = mine > 0u ? mine : 1u; nx = cnt > 0u ? cnt : 1u;
}
DI void xcd_barrier(const XcdBarrier& b) {
    asm volatile("s_waitcnt vmcnt(0)" ::: "memory");
    __syncthreads();
    if (threadIdx.x == 0) {
        unsigned* bar = b.bar; asm volatile("" : "+s"(bar));
        __builtin_amdgcn_s_waitcnt(0);
        unsigned nloc = b.st[0], nx = b.st[1];
        if (nloc == 0u) { xcd_barrier_complete(bar, b.x, nloc, nx); b.st[0] = nloc; b.st[1] = nx; }
        const unsigned old = xb_add(&bar[XB_XSUB(b.x)], 1u);
        const unsigned gen = old / nloc;
        if (old + 1u == (gen + 1u) * nloc) {
            __builtin_amdgcn_fence(__ATOMIC_RELEASE, "agent");
            asm volatile("s_waitcnt vmcnt(0)" ::: "memory");
            const unsigned og = xb_add(&bar[XB_TOP], 1u);
            const unsigned tg = og / nx;
            if (og + 1u == (tg + 1u) * nx) xb_add(&bar[XB_TOPGEN], 1u);
            else XB_SPIN(xb_ld(&bar[XB_TOPGEN]) == tg, bar);
            __builtin_amdgcn_fence(__ATOMIC_ACQUIRE, "agent");
            xb_add(&bar[XB_XGEN(b.x)], 1u);
            asm volatile("s_waitcnt vmcnt(0)" ::: "memory");
        } else {
            XB_SPIN(xb_ld(&bar[XB_XGEN(b.x)]) == gen, bar);
            __builtin_amdgcn_fence(__ATOMIC_ACQUIRE, "agent");
            asm volatile("s_waitcnt vmcnt(0)" ::: "memory");
        }
    }
    __syncthreads();
}

DI void grp_barrier(unsigned* cnt, unsigned& gen, bool same_xcd) {
    asm volatile("s_waitcnt vmcnt(0)" ::: "memory");
    __syncthreads();
    if (threadIdx.x == 0) {
        __builtin_amdgcn_s_waitcnt(0);
        if (!same_xcd) { __builtin_amdgcn_fence(__ATOMIC_RELEASE, "agent"); asm volatile("s_waitcnt vmcnt(0)" ::: "memory"); }
        (void)xb_add(cnt, 1u);
        const unsigned target = 16u * (gen + 1u); unsigned sp = 0;
        while (xb_ld(cnt) < target) { __builtin_amdgcn_s_sleep(1); if (++sp > XB_SPIN_CAP) break; }
        __builtin_amdgcn_fence(__ATOMIC_ACQUIRE, "agent");
        asm volatile("s_waitcnt vmcnt(0)" ::: "memory");
    }
    ++gen;
    __syncthreads();
}

template <int RMAP> DI int rmap(int n) { return RMAP == 0 ? n : (RMAP == 1 ? (n >> 7) * 256 + (n & 127) : (RMAP == 2 ? (n >> 7) * 256 + 128 + (n & 127) : (n & ~31) + 8 * ((n >> 2) & 3) + 4 * ((n >> 4) & 1) + (n & 3))); }
template <int RMAP>
DI void cvt_weight(const float* W, int K, int ldw, int c0, int N, bf16_t* WT, int row_off, const float* gk, const float* gn, float scale, LAS float* scr_, int& rot, int NGW, int lane) {
    LAS bf16_t* scr = (LAS bf16_t*)scr_;
    const int nblk = N / 64, nitems = (K / 64) * nblk;
    const int first = rot; rot = (rot + NGW - nitems % NGW) % NGW;
    const int lr = lane >> 4, lc = (lane & 15) * 4;
    for (int item = first; item < nitems; item += NGW) {
        const int kb = item / nblk, nb = item % nblk, k0 = 64 * kb, n0 = 64 * nb;
        f32x4 gnv = {scale, scale, scale, scale};
        if (gn) { const f32x4 t = *(const f32x4*)(gn + n0 + lc); gnv = t * scale; }
        f32x4 v[16]; float gkq[16];
#pragma unroll
        for (int i = 0; i < 16; ++i) v[i] = *(const f32x4*)(W + (size_t)(k0 + 4 * i + lr) * ldw + c0 + n0 + lc);
#pragma unroll
        for (int i = 0; i < 16; ++i) gkq[i] = gk ? gk[k0 + 4 * i + lr] : 1.f;
        asm volatile("" ::: "memory");
#pragma unroll
        for (int i = 0; i < 16; ++i) { const int kk = 4 * i + lr; const float gkv = gkq[i]; const f32x4 o = v[i] * gnv * gkv;
            scr[(lc + 0) * 72 + kk] = (bf16_t)(cvtpk(o[0], 0.f) & 0xffffu); scr[(lc + 1) * 72 + kk] = (bf16_t)(cvtpk(o[1], 0.f) & 0xffffu);
            scr[(lc + 2) * 72 + kk] = (bf16_t)(cvtpk(o[2], 0.f) & 0xffffu); scr[(lc + 3) * 72 + kk] = (bf16_t)(cvtpk(o[3], 0.f) & 0xffffu); }
        LDS_WAIT(); asm volatile("" ::: "memory");
#pragma unroll
        for (int j = 0; j < 8; ++j) { const int n = 8 * j + (lane >> 3), c = lane & 7; const u32x4 o = *(const LAS u32x4*)(scr + n * 72 + 8 * c);
            *(u32x4*)(WT + (size_t)(row_off + rmap<RMAP>(n0 + n)) * K + k0 + 8 * c) = o; }
        LDS_WAIT(); asm volatile("" ::: "memory");
    }
}
DI void cvt_rows(const float* W, int K, bf16_t* dst, const float* gk, float scale, int& rot, int NGW, int lane) {
    const int first = rot; rot = (rot + NGW - K % NGW) % NGW;
    for (int k = first; k < K; k += NGW) { const float g = gk[k] * scale; const f32x4* xr = (const f32x4*)(W + (size_t)k * DM) + lane; u32x2* o8 = (u32x2*)(dst + (size_t)k * DM) + lane;
#pragma unroll
        for (int j = 0; j < 4; ++j) { const f32x4 v = xr[64 * j] * g; u32x2 w; w.x = cvtpk(v[0], v[1]); w.y = cvtpk(v[2], v[3]); o8[64 * j] = w; } }
}
DI void rows_to_bf16(const float* X, bf16_t* XB, float* RSTD, int nrows, float* Xcopy, int gw, int NGW, int lane) {
    asm volatile("" : "+v"(lane));
    (void)Xcopy;
    for (int row0 = 2 * gw; row0 < nrows; row0 += 2 * NGW) {
        f32x4 v[2][4]; float s[2];
#pragma unroll
        for (int k = 0; k < 2; ++k) { const f32x4* xr = (const f32x4*)(X + (size_t)(row0 + k) * DM) + lane;
#pragma unroll
            for (int j = 0; j < 4; ++j) v[k][j] = xr[64 * j]; }
#pragma unroll
        for (int k = 0; k < 2; ++k) { float q = 0.f;
#pragma unroll
            for (int j = 0; j < 4; ++j) q += (v[k][j][0] * v[k][j][0] + v[k][j][1] * v[k][j][1]) + (v[k][j][2] * v[k][j][2] + v[k][j][3] * v[k][j][3]);
            s[k] = wave_sum(q); }
#pragma unroll
        for (int k = 0; k < 2; ++k) {
            if (lane == 0) *(f32x4*)(RSTD + (size_t)(row0 + k) * 4) = (f32x4){s[k], 0.f, 0.f, 0.f};
            u32x2* o8 = (u32x2*)(XB + (size_t)(row0 + k) * DM) + lane;
#pragma unroll
            for (int j = 0; j < 4; ++j) { u32x2 w; w.x = cvtpk(v[k][j][0], v[k][j][1]); w.y = cvtpk(v[k][j][2], v[k][j][3]); o8[64 * j] = w; } }
    }
}
DI void pool_pre(const bf16_t* X, const float* SSQ, const float* gpre, bf16_t* DP, int run0, int run_end, int run_step, int tid) {
    asm volatile("" : "+v"(tid));
    const int lane = tid & 63;
    const int c = 4 * (tid & 255), w = __builtin_amdgcn_readfirstlane(2 << (c >> 8));
    const f32x4 g = *(const f32x4*)(gpre + c);
    const float invw = __builtin_amdgcn_rcpf((float)w);
    for (int run = run0 + (tid >> 8) * run_step; run < run_end; run += 2 * run_step) {
        const int r0 = run * 64, tp0 = r0 & (SEQ - 1);
        const int ra = r0 - 16 + lane;
        const int rsA = __float_as_int(rstd_of(SSQ, ra < 0 ? 0 : ra)), rsB = __float_as_int(rstd_of(SSQ, r0 + 48 + (lane & 15)));
#define PP_RS(row_) (((row_) - (r0 - 16)) < 64 ? __int_as_float(__builtin_amdgcn_readlane(rsA, (row_) - (r0 - 16))) : __int_as_float(__builtin_amdgcn_readlane(rsB, (row_) - (r0 + 48))))
        f32x4 s = {0.f, 0.f, 0.f, 0.f};
        for (int j = 1; j < w; ++j) { if (tp0 - j >= 0) { const u32x2 xv = *(const u32x2*)(X + (size_t)(r0 - j) * DM + c); const float rs = PP_RS(r0 - j);
            s += (f32x4){bflo(xv.x), bfhi(xv.x), bflo(xv.y), bfhi(xv.y)} * rs * g; } }
#pragma unroll 1
        for (int i0 = 0; i0 < 64; i0 += 8) {
            u32x2 xv[8], xl[8];
#pragma unroll
            for (int k = 0; k < 8; ++k) { const int row = r0 + i0 + k, tp = tp0 + i0 + k; const int lrow = (tp - w + 1 >= 0) ? row - w + 1 : row;
                xv[k] = *(const u32x2*)(X + (size_t)row * DM + c); xl[k] = *(const u32x2*)(X + (size_t)lrow * DM + c); }
#pragma unroll
            for (int k = 0; k < 8; ++k) { const int row = r0 + i0 + k, tp = tp0 + i0 + k; const int lrow = (tp - w + 1 >= 0) ? row - w + 1 : row;
                const float rsk = PP_RS(row), rlk = PP_RS(lrow);
                const f32x4 h = (f32x4){bflo(xv[k].x), bfhi(xv[k].x), bflo(xv[k].y), bfhi(xv[k].y)} * rsk * g;
                s += h;
                const float inv = (tp + 1 < w) ? __builtin_amdgcn_rcpf((float)(tp + 1)) : invw;
                const f32x4 d = s * inv - h;
                u32x2 o; o.x = cvtpk(d[0], d[1]); o.y = cvtpk(d[2], d[3]);
                *(u32x2*)(DP + (size_t)row * DM + c) = o;
                if (tp - w + 1 >= 0) s -= (f32x4){bflo(xl[k].x), bfhi(xl[k].x), bflo(xl[k].y), bfhi(xl[k].y)} * rlk * g; }
        }
#undef PP_RS
    }
}

#define MFMA32(a, b, c) __builtin_amdgcn_mfma_f32_32x32x16_bf16((a), (b), (c), 0, 0, 0)
#define MFMA16(a, b, c) __builtin_amdgcn_mfma_f32_16x16x32_bf16((a), (b), (c), 0, 0, 0)
#define SB_SUBTILE(Z, DIAG, ALLV, A, RUN) do { float sg_[16], kp_[16]; \
        _Pragma("unroll") for (int i = 0; i < 16; ++i) { const int ko = (i & 3) + 8 * (i >> 2) + 4 * hh; const bool valid = (ALLV) && (!(DIAG) || (ko < r)); \
              \
            const float zz = __builtin_amdgcn_fmed3f(Z[i], -126.0f, 126.0f), e = ex2(-zz), rc = __builtin_amdgcn_rcpf(1.0f + e), er = e * rc; \
            sg_[i] = valid ? rc : 0.f; kp_[i] = valid ? er : 1.f; } \
        float pg_[4], tg_[4];        \
        _Pragma("unroll") for (int g = 0; g < 4; ++g) { const float gp_ = (kp_[4 * g] * kp_[4 * g + 1]) * (kp_[4 * g + 2] * kp_[4 * g + 3]); \
            const auto sw_ = __builtin_amdgcn_permlane32_swap(__float_as_uint(gp_), __float_as_uint(gp_), false, false); const float r0_ = __uint_as_float(sw_[0]), r1_ = __uint_as_float(sw_[1]); \
            pg_[g] = r0_ * r1_; tg_[g] = hh ? 1.f : r1_; } \
        float run_ = 1.f, aft_[4]; \
        _Pragma("unroll") for (int g = 3; g >= 0; --g) { aft_[g] = run_ * tg_[g]; run_ *= pg_[g]; } \
        _Pragma("unroll") for (int g = 0; g < 4; ++g) { float c = aft_[g] * F; \
            _Pragma("unroll") for (int k = 3; k >= 0; --k) { A[4 * g + k] = sg_[4 * g + k] * c; c *= kp_[4 * g + k]; } } \
        RUN = run_; } while (0)
DI void sb_attention(const bf16_t* QK, const bf16_t* VT, bf16_t* O, LAS unsigned char* lds, int vcu, int G, int tid_in) {
    int tid = tid_in; asm volatile("" : "+v"(tid));
    const int lane = tid & 63, wave = __builtin_amdgcn_readfirstlane(tid >> 6), r = lane & 31, hh = lane >> 5;
    for (int bh = vcu; bh < NB * 16; bh += G) {
        const int h = bh & 15, b = bh >> 4;
        const bf16_t* kbase = QK + (size_t)(b * SEQ + r) * 2048 + 1024 + h * 64 + 8 * hh;
        const bf16_t* vbase = VT + ((size_t)b * 1024 + h * 64 + r) * LDT + 4 * hh;
        unsigned koff[4], voff[4];
#pragma unroll
        for (int q = 0; q < 4; ++q) { const int sl = (wave * 4 + q) * 64 + lane;
            { const int row = sl >> 3, piece = (sl & 7) ^ (row & 7); koff[q] = (unsigned)(row * 2048 + piece * 8); }
            { const int d = sl >> 5, sp = sl & 31; voff[q] = (unsigned)(d * LDT + (sp ^ (d & 15)) * 8); } }
#pragma unroll 1
        for (int unit = 0; unit < SEQ / 256; ++unit) {
            const int T0 = unit * 256, half = unit & 1, t0 = T0 + wave * 32;
            const bf16_t* qp = QK + (size_t)(b * SEQ + t0 + r) * 2048 + h * 64 + 8 * hh;
            bf16x8 qf[4];
#pragma unroll
            for (int s = 0; s < 4; ++s) qf[s] = *(const bf16x8*)(qp + 16 * s);
            asm volatile("s_waitcnt lgkmcnt(0)" ::: "memory"); __builtin_amdgcn_s_barrier(); asm volatile("" ::: "memory");
            {   const bf16_t* ksrc = QK + (size_t)(b * SEQ + T0) * 2048 + 1024 + h * 64; const bf16_t* vsrc = VT + ((size_t)b * 1024 + h * 64) * LDT + T0;
#pragma unroll
                for (int q = 0; q < 4; ++q) {
                    __builtin_amdgcn_global_load_lds((const unsigned*)(ksrc + koff[q]), (LAS unsigned*)(lds + half * 32768 + (wave * 4 + q) * 1024), 16, 0, 0);
                    __builtin_amdgcn_global_load_lds((const unsigned*)(vsrc + voff[q]), (LAS unsigned*)(lds + 65536 + half * 32768 + (wave * 4 + q) * 1024), 16, 0, 0); } }
            asm volatile("s_waitcnt vmcnt(0)" ::: "memory"); __builtin_amdgcn_s_barrier(); asm volatile("" ::: "memory");
            const int ring_lo = T0 >= 256 ? T0 - 256 : 0;
            f32x16 o0, o1;
#pragma unroll
            for (int i = 0; i < 16; ++i) { o0[i] = 0.f; o1[i] = 0.f; }
            float F = 1.f, R = 0.f;
            int sb = t0 - 32;
            for (;;) {
                const bool lval = sb >= 0; const int sbl = lval ? sb : 0, sbh = sb + 32;
                bf16x8 kH[4], kL[4]; bf16x4 vH[2][2][2], vL[2][2][2];
                if (sbl >= ring_lo) {
                    const int rh = (sbh + r) & 511, rl = (sbl + r) & 511;
#pragma unroll
                    for (int s = 0; s < 4; ++s) { kH[s] = *(const LAS bf16x8*)(lds + rh * 128 + (((2 * s + hh) ^ (rh & 7)) << 4)); kL[s] = *(const LAS bf16x8*)(lds + rl * 128 + (((2 * s + hh) ^ (rl & 7)) << 4)); }
#pragma unroll
                    for (int dt = 0; dt < 2; ++dt)
#pragma unroll
                        for (int s = 0; s < 2; ++s)
#pragma unroll
                            for (int p = 0; p < 2; ++p) { const int d = 32 * dt + r; const int ph = ((sbh & 255) >> 3) + 2 * s + p, pl = ((sbl & 255) >> 3) + 2 * s + p;
                                vH[dt][s][p] = *(const LAS bf16x4*)(lds + 65536 + ((sbh >> 8) & 1) * 32768 + d * 512 + ((ph ^ (d & 15)) << 4) + hh * 8);
                                vL[dt][s][p] = *(const LAS bf16x4*)(lds + 65536 + ((sbl >> 8) & 1) * 32768 + d * 512 + ((pl ^ (d & 15)) << 4) + hh * 8); }
                } else {
#pragma unroll
                    for (int s = 0; s < 4; ++s) { kH[s] = *(const bf16x8*)(kbase + (size_t)sbh * 2048 + 16 * s); kL[s] = *(const bf16x8*)(kbase + (size_t)sbl * 2048 + 16 * s); }
#pragma unroll
                    for (int dt = 0; dt < 2; ++dt)
#pragma unroll
                        for (int s = 0; s < 2; ++s)
#pragma unroll
                            for (int p = 0; p < 2; ++p) { vH[dt][s][p] = *(const bf16x4*)(vbase + (size_t)dt * 32 * LDT + sbh + 16 * s + 8 * p); vL[dt][s][p] = *(const bf16x4*)(vbase + (size_t)dt * 32 * LDT + sbl + 16 * s + 8 * p); }
                }
                const int nsb = sb - 64; const bool more = nsb >= -32;
                f32x16 zH, zL;
#pragma unroll
                for (int i = 0; i < 16; ++i) { zH[i] = 0.f; zL[i] = 0.f; }
#pragma unroll
                for (int s = 0; s < 4; ++s) { zH = MFMA32(kH[s], qf[s], zH); zL = MFMA32(kL[s], qf[s], zL); }
                float aH[16], aL[16], runH, runL;
                if (sbh == t0) SB_SUBTILE(zH, true, true, aH, runH); else SB_SUBTILE(zH, false, true, aH, runH);
                F *= runH;
                if (lval) SB_SUBTILE(zL, false, true, aL, runL);
                else {
#pragma unroll
                    for (int i = 0; i < 16; ++i) aL[i] = 0.f;
                    runL = 1.f; }
                F *= runL;
                R -= lg2(runH) + lg2(runL);
#pragma unroll
                for (int s = 0; s < 2; ++s) {
                    u32x4 w; w.x = cvtpk(aH[8 * s + 0], aH[8 * s + 1]); w.y = cvtpk(aH[8 * s + 2], aH[8 * s + 3]); w.z = cvtpk(aH[8 * s + 4], aH[8 * s + 5]); w.w = cvtpk(aH[8 * s + 6], aH[8 * s + 7]);
                    const bf16x8 pH = __builtin_bit_cast(bf16x8, w);
                    w.x = cvtpk(aL[8 * s + 0], aL[8 * s + 1]); w.y = cvtpk(aL[8 * s + 2], aL[8 * s + 3]); w.z = cvtpk(aL[8 * s + 4], aL[8 * s + 5]); w.w = cvtpk(aL[8 * s + 6], aL[8 * s + 7]);
                    const bf16x8 pL = __builtin_bit_cast(bf16x8, w);
                    o0 = MFMA32(__builtin_shufflevector(vH[0][s][0], vH[0][s][1], 0, 1, 2, 3, 4, 5, 6, 7), pH, o0); o1 = MFMA32(__builtin_shufflevector(vH[1][s][0], vH[1][s][1], 0, 1, 2, 3, 4, 5, 6, 7), pH, o1);
                    o0 = MFMA32(__builtin_shufflevector(vL[0][s][0], vL[0][s][1], 0, 1, 2, 3, 4, 5, 6, 7), pL, o0); o1 = MFMA32(__builtin_shufflevector(vL[1][s][0], vL[1][s][1], 0, 1, 2, 3, 4, 5, 6, 7), pL, o1); }
                if (!more) break;
                if (__all(R >= 151.0f)) break;
                sb = nsb;
            }
            bf16_t* op = O + (size_t)(b * SEQ + t0 + r) * DM + h * 64 + 4 * hh;
#pragma unroll
            for (int g = 0; g < 4; ++g) {
                u32x2 w; w.x = cvtpk(o0[4 * g], o0[4 * g + 1]); w.y = cvtpk(o0[4 * g + 2], o0[4 * g + 3]); *(u32x2*)(op + 8 * g) = w;
                w.x = cvtpk(o1[4 * g], o1[4 * g + 1]); w.y = cvtpk(o1[4 * g + 2], o1[4 * g + 3]); *(u32x2*)(op + 32 + 8 * g) = w; }
        }
        asm volatile("s_waitcnt lgkmcnt(0)" ::: "memory"); __builtin_amdgcn_s_barrier(); asm volatile("" ::: "memory");
    }
}

DI void ret_scores(const bf16_t* QKn, bf16_t* SC, int u0, int u_end, int u_step, int lane) {
    asm volatile("" : "+v"(lane));
    const int fr = lane & 15, fq = lane >> 4;
    for (int u = u0; u < u_end; u += u_step) {
        const int c = u & 63, h = (u >> 6) & 3, bl = u >> 8;
        const bf16_t* qb = QKn + (size_t)(bl * SEQ + c * 64) * 2048 + h * 256 + 8 * fq;
        const bf16_t* kbp = qb + 1024;
        bf16_t* sc = SC + (size_t)u * 4096;
#pragma unroll 1
        for (int nt = 0; nt < 4; ++nt) {
            bf16x8 qf[8];
#pragma unroll
            for (int ks = 0; ks < 8; ++ks) qf[ks] = *(const bf16x8*)(qb + (size_t)(16 * nt + fr) * 2048 + 32 * ks);
#pragma unroll 1
            for (int mt = 0; mt < 4; ++mt) {
                f32x4 acc = {0.f, 0.f, 0.f, 0.f};
                if (mt <= nt) {
#pragma unroll
                    for (int ks = 0; ks < 8; ++ks) { const bf16x8 kr = *(const bf16x8*)(kbp + (size_t)(16 * mt + fr) * 2048 + 32 * ks); const bf16x8 kf = (fr & 8) ? __builtin_shufflevector(kr, kr, 4, 5, 6, 7, 0, 1, 2, 3) : kr;     acc = MFMA16(kf, qf[ks], acc); }
                    const int n = 16 * nt + fr;
#pragma unroll
                    for (int i = 0; i < 4; ++i) { const int m = 16 * mt + 4 * fq + i; acc[i] = (n >= m) ? acc[i] : 0.f; }
                }
                u32x2 w; w.x = cvtpk(acc[0], acc[1]); w.y = cvtpk(acc[2], acc[3]);
                *(u32x2*)(sc + (16 * nt + fr) * 64 + 16 * mt + 4 * fq) = w;
            }
        }
    }
}
DI void ret_scan(const bf16_t* QKn, const bf16_t* KVT, const bf16_t* SC, bf16_t* O, float* gns, LAS unsigned char* lds, int vcu, int G, int tid_in) {
    int tid = tid_in; asm volatile("" : "+v"(tid));
    const int lane = tid & 63, wave = __builtin_amdgcn_readfirstlane(tid >> 6), fr = lane & 15, fq = lane >> 4;
    LAS unsigned char* OUT = lds + SMX_OFF;
    constexpr int OUTP = 272;
    for (int task = vcu; task < NB * 16; task += G) {
        const int eb = task & 3, h = (task >> 2) & 3, bl = task >> 4, e0 = eb * 128 + wave * 16;
        const float g64 = ex2(64.0f * lg2(1.0f - ex2(-5.0f - (float)h)));
        const bf16_t* qsrc = QKn + (size_t)(bl * SEQ) * 2048 + h * 256;
        const bf16_t* vtp = KVT + (size_t)bl * 2048 * LDR + (size_t)(h * 512 + e0 + fr) * LDR + 8 * fq;
        const bf16_t* scp = SC + (size_t)((bl * 4 + h) * 64) * 4096 + fr * 64 + 8 * fq;
        bf16_t* ob = O + (size_t)(bl * SEQ) * 2048 + h * 512 + eb * 128;
#define RS_DMA(c_, buf_) do { int ln_ = lane; asm volatile("" : "+v"(ln_)); _Pragma("unroll") for (int q = 0; q < 4; ++q) { const int sl = (wave * 4 + q) * 64 + ln_, row = sl >> 5; \
            const unsigned qo = (unsigned)(row * 2048 + (((sl & 31) ^ (row & 15)) << 3)), ko = (unsigned)(row * 2048 + (((sl & 31) ^ ((row & 3) << 2)) << 3)) + 1024u;     \
            __builtin_amdgcn_global_load_lds((const unsigned*)(qsrc + (size_t)(c_) * 64 * 2048 + qo), (LAS unsigned*)(lds + (buf_) * 65536 + (wave * 4 + q) * 1024), 16, 0, 0); \
            __builtin_amdgcn_global_load_lds((const unsigned*)(qsrc + (size_t)(c_) * 64 * 2048 + ko), (LAS unsigned*)(lds + (buf_) * 65536 + 32768 + (wave * 4 + q) * 1024), 16, 0, 0); } } while (0)
#define RS_STORE_OUT(c_) do { _Pragma("unroll") for (int q = 0; q < 2; ++q) { const int idx = tid + 512 * q, p = idx >> 4, pc = idx & 15; \
            const u32x4 v = *(const LAS u32x4*)(OUT + p * OUTP + pc * 16); *(u32x4*)(ob + (size_t)(p * 64 + (c_)) * 2048 + pc * 8) = v; \
            const float a0 = bflo(v.x), a1 = bfhi(v.x), a2 = bflo(v.y), a3 = bfhi(v.y), a4 = bflo(v.z), a5 = bfhi(v.z), a6 = bflo(v.w), a7 = bfhi(v.w); \
            float s1 = ((a0 + a1) + (a2 + a3)) + ((a4 + a5) + (a6 + a7)), s2 = ((a0 * a0 + a1 * a1) + (a2 * a2 + a3 * a3)) + ((a4 * a4 + a5 * a5) + (a6 * a6 + a7 * a7)); \
            s1 = rowsum16(s1); s2 = rowsum16(s2); \
            if (pc == 0) *(f32x2*)(gns + (size_t)(bl * SEQ + p * 64 + (c_)) * 32 + h * 8 + eb * 2) = (f32x2){s1, s2}; } } while (0)
        f32x4 S[16];
#pragma unroll
        for (int T = 0; T < 16; ++T) S[T] = (f32x4){0.f, 0.f, 0.f, 0.f};
        bf16x8 scr[8], vcur[2], vnext[2];
        RS_DMA(0, 0);
#pragma unroll
        for (int k2 = 0; k2 < 2; ++k2) { vcur[k2] = *(const bf16x8*)(vtp + 32 * k2); vnext[k2] = vcur[k2]; }
#pragma unroll
        for (int k2 = 0; k2 < 2; ++k2)
#pragma unroll
            for (int nt = 0; nt < 4; ++nt) scr[k2 * 4 + nt] = *(const bf16x8*)(scp + (16 * nt) * 64 + 32 * k2);
#pragma unroll 1
        for (int c = 0; c < 64; ++c) {
            asm volatile("s_waitcnt vmcnt(0) lgkmcnt(0)" ::: "memory"); __builtin_amdgcn_s_barrier(); asm volatile("" ::: "memory");
            const int buf = c & 1;
            if (c + 1 < 64) { RS_DMA(c + 1, buf ^ 1);
#pragma unroll
                for (int k2 = 0; k2 < 2; ++k2) vnext[k2] = *(const bf16x8*)(vtp + (c + 1) * 64 + 32 * k2); }
            if (c > 0) RS_STORE_OUT(c - 1);
            const LAS unsigned char* Qb = lds + buf * 65536; LAS unsigned char* Kb = lds + buf * 65536 + 32768;
            int q4 = fr >> 2; asm volatile("" : "+v"(q4));
            LAS unsigned char* krow = Kb + (8 * fq + q4) * 512 + (fr & 3) * 16;
            f32x4 acc[4];
#pragma unroll
            for (int nt = 0; nt < 4; ++nt) acc[nt] = (f32x4){0.f, 0.f, 0.f, 0.f};
            bf16x8 aQ[3][4];
#define RS_QREAD(bufi, KS) do { const unsigned qa_ = (unsigned)(size_t)(Qb + fr * 512 + (((4 * (KS) + fq) ^ fr) << 4)); \
                asm volatile("ds_read_b128 %0, %1" : "=v"(aQ[bufi][0]) : "v"(qa_)); asm volatile("ds_read_b128 %0, %1 offset:8192" : "=v"(aQ[bufi][1]) : "v"(qa_)); \
                asm volatile("ds_read_b128 %0, %1 offset:16384" : "=v"(aQ[bufi][2]) : "v"(qa_)); asm volatile("ds_read_b128 %0, %1 offset:24576" : "=v"(aQ[bufi][3]) : "v"(qa_)); } while (0)
#define RS_QWAIT(bufi, N) asm volatile("s_waitcnt lgkmcnt(" #N ")" : "+v"(aQ[bufi][0]), "+v"(aQ[bufi][1]), "+v"(aQ[bufi][2]), "+v"(aQ[bufi][3]))
            RS_QREAD(0, 0); RS_QREAD(1, 1);
#pragma unroll
            for (int ks = 0; ks < 8; ++ks) {
                if (ks < 6) { RS_QREAD((ks + 2) % 3, ks + 2); RS_QWAIT(ks % 3, 8); }
                else if (ks == 6) RS_QWAIT(ks % 3, 4);
                else RS_QWAIT(ks % 3, 0);
                u32x4 w; w.x = cvtpk(S[2 * ks][0], S[2 * ks][1]); w.y = cvtpk(S[2 * ks][2], S[2 * ks][3]); w.z = cvtpk(S[2 * ks + 1][0], S[2 * ks + 1][1]); w.w = cvtpk(S[2 * ks + 1][2], S[2 * ks + 1][3]);
                const bf16x8 bS = __builtin_bit_cast(bf16x8, w);
#pragma unroll
                for (int nt = 0; nt < 4; ++nt) acc[nt] = MFMA16(bS, aQ[ks % 3][nt], acc[nt]);
            }
#undef RS_QREAD
#undef RS_QWAIT
#pragma unroll
            for (int nt = 0; nt < 4; ++nt) acc[nt] *= g64;
#pragma unroll
            for (int k2 = 0; k2 < 2; ++k2)
#pragma unroll
                for (int nt = 0; nt < 4; ++nt) acc[nt] = MFMA16(vcur[k2], scr[k2 * 4 + nt], acc[nt]);
            if (c + 1 < 64) {
#pragma unroll
                for (int k2 = 0; k2 < 2; ++k2)
#pragma unroll
                    for (int nt = 0; nt < 4; ++nt) scr[k2 * 4 + nt] = *(const bf16x8*)(scp + (size_t)(c + 1) * 4096 + (16 * nt) * 64 + 32 * k2); }
            asm volatile("s_waitcnt lgkmcnt(0)" ::: "memory"); __builtin_amdgcn_s_barrier(); asm volatile("" ::: "memory");
#pragma unroll
            for (int nt = 0; nt < 4; ++nt) { u32x2 w; w.x = cvtpk(acc[nt][0], acc[nt][1]); w.y = cvtpk(acc[nt][2], acc[nt][3]);
                *(LAS u32x2*)(OUT + (16 * nt + fr) * OUTP + wave * 32 + fq * 8) = w; }
            const int hsw8 = (fq & 1) * 8;
            bf16x4 kf[4][4];
#define RS_KREAD(bufi, TT) do { const unsigned ka_ = (unsigned)(size_t)(krow + (((((TT) >> 1) ^ q4) << 6) + ((((TT) & 1) * 8) ^ hsw8))); \
                asm volatile("ds_read_b64_tr_b16 %0, %1" : "=v"(kf[bufi][0]) : "v"(ka_)); asm volatile("ds_read_b64_tr_b16 %0, %1 offset:2048" : "=v"(kf[bufi][1]) : "v"(ka_)); \
                asm volatile("ds_read_b64_tr_b16 %0, %1 offset:16384" : "=v"(kf[bufi][2]) : "v"(ka_)); asm volatile("ds_read_b64_tr_b16 %0, %1 offset:18432" : "=v"(kf[bufi][3]) : "v"(ka_)); } while (0)
#define RS_KWAIT(bufi, N) asm volatile("s_waitcnt lgkmcnt(" #N ")" : "+v"(kf[bufi][0]), "+v"(kf[bufi][1]), "+v"(kf[bufi][2]), "+v"(kf[bufi][3]))
            RS_KREAD(0, 0); RS_KREAD(1, 1); RS_KREAD(2, 2);
#pragma unroll
            for (int T = 0; T < 16; ++T) {
                if (T < 13) { RS_KREAD((T + 3) & 3, T + 3); RS_KWAIT(T & 3, 12); }
                else if (T == 13) RS_KWAIT(T & 3, 8);
                else if (T == 14) RS_KWAIT(T & 3, 4);
                else RS_KWAIT(T & 3, 0);
                f32x4 sv = S[T] * g64;
#pragma unroll
                for (int k2 = 0; k2 < 2; ++k2) { const bf16x8 aK = __builtin_shufflevector(kf[T & 3][2 * k2], kf[T & 3][2 * k2 + 1], 0, 1, 2, 3, 4, 5, 6, 7); sv = MFMA16(aK, vcur[k2], sv); }
                S[T] = sv;
            }
#undef RS_KWAIT
#undef RS_KREAD
            vcur[0] = vnext[0]; vcur[1] = vnext[1];
        }
        asm volatile("s_waitcnt vmcnt(0) lgkmcnt(0)" ::: "memory"); __builtin_amdgcn_s_barrier(); asm volatile("" ::: "memory");
        RS_STORE_OUT(63);
        asm volatile("s_waitcnt lgkmcnt(0)" ::: "memory"); __builtin_amdgcn_s_barrier(); asm volatile("" ::: "memory");
#undef RS_DMA
#undef RS_STORE_OUT
    }
}
DI GAS unsigned char* opq(unsigned char* p) { GAS unsigned char* q = (GAS unsigned char*)p; asm volatile("" : "+s"(q)); return q; }
struct Args { const float* in[21]; float* out; unsigned char* ws; };
static_assert(sizeof(Args) == 23 * 8, "no padding");

__global__ void __launch_bounds__(512, 2) fwd_kernel(Args args) {
    extern __shared__ __attribute__((aligned(16))) unsigned char lds_raw[];
    LAS unsigned char* lds = (LAS unsigned char*)lds_raw;
    volatile LAS unsigned* MISC = (volatile LAS unsigned*)(lds + MISC_OFF);
    const int tid = threadIdx.x, lane = tid & 63, wave = __builtin_amdgcn_readfirstlane(tid >> 6);
    const int G = gridDim.x, bx = blockIdx.x, vcu = (G % 8 == 0) ? (bx % 8) * (G / 8) + bx / 8 : bx;
    const int gw = vcu * 8 + wave, NGW = G * 8;
    const int grp = vcu >> 4, wg16 = vcu & 15;
    unsigned char* ws = args.ws;
    unsigned* ctl = (unsigned*)(ws + WS_CTL);
    for (int u = tid; u < 64; u += 512) ((LAS unsigned*)(lds + MISC_OFF))[u] = 0u;
    __syncthreads();
    XcdBarrier bar = xcd_barrier_post(ctl + CW_BAR, MISC + 8);
#define GRID_BAR() xcd_barrier(bar)
    if (tid == 0) (void)__hip_atomic_fetch_or(ctl + CW_GRP + 64 * (16 + (vcu >> 4)), 1u << xb_xcc_id(), __ATOMIC_RELAXED, __HIP_MEMORY_SCOPE_AGENT);

    const float* x_in = args.in[0]; const float* mem = args.in[1];
    const float* n_mix_pre = args.in[2]; const float* n_mix_post = args.in[3]; const float* n_xa_pre = args.in[4]; const float* n_xa_post = args.in[5];
    const float* n_mem = args.in[6]; const float* n_ffn_pre = args.in[7]; const float* n_ffn_post = args.in[8];
    const float* pool_w = args.in[9]; const float* pool_scale = args.in[10]; const float* sb_w_in = args.in[11]; const float* sb_w_out = args.in[12];
    const float* ret_w_in = args.in[13]; const float* ret_gn = args.in[14]; const float* ret_w_out = args.in[15];
    const float* xa_w_q = args.in[16]; const float* xa_w_kv = args.in[17]; const float* xa_w_o = args.in[18]; const float* ffn_w_in = args.in[19]; const float* ffn_w_out = args.in[20];
    float* X = args.out;
#define RSTD  ((float*)(GAS float*)(opq(ws) + WS_SSQ))
#define MRSTD ((float*)(GAS float*)(opq(ws) + WS_MRSTD))
#define cosN  ((float*)(GAS float*)(opq(ws) + WS_ROPE))
#define sinN  ((float*)(GAS float*)(opq(ws) + WS_ROPE + 2 * MiB))
#define cosT  ((float*)(GAS float*)(opq(ws) + WS_ROPE + 4 * MiB))
#define sinT  ((float*)(GAS float*)(opq(ws) + WS_ROPE + 6 * MiB))
#define MEMB  ((bf16_t*)(GAS bf16_t*)(opq(ws) + WS_MEMB))
#define KMEM  ((bf16_t*)(GAS bf16_t*)(opq(ws) + WS_KMEM))
#define VTMEM ((bf16_t*)(GAS bf16_t*)(opq(ws) + WS_VTMEM))
#define WB    ((bf16_t*)(GAS bf16_t*)(opq(ws) + WS_WB))
#define XB    ((bf16_t*)(GAS bf16_t*)(opq(ws) + WS_XB))
#define R     ((unsigned char*)(opq(ws) + WS_R))

    {
        LAS float* scr = (LAS float*)(lds + wave * 16384); int rot = gw;
        for (int j = 0; j < 2; ++j) {
            for (int g = 0; g < 4; ++g)
                cvt_weight<0>(pool_w + (size_t)(j * 4 + g) * 65536, 256, 256, 0, 256, WB + WO_POOL + (size_t)(j * 4 + g) * 65536, 0, nullptr, pool_scale + j * DM + g * 256, 1.f, scr, rot, NGW, lane);
        }
        cvt_weight<0>(sb_w_in, 1024, 3072, 0, 1024, WB + WO_SB_QK, 0, n_mix_pre + 1 * DM, nullptr, 0.125f * LOG2E, scr, rot, NGW, lane);
        cvt_weight<0>(sb_w_in, 1024, 3072, 1024, 1024, WB + WO_SB_QK, 1024, n_mix_pre + 1 * DM, nullptr, 1.f, scr, rot, NGW, lane);
        cvt_weight<0>(sb_w_in, 1024, 3072, 2048, 1024, WB + WO_SB_V, 0, n_mix_pre + 1 * DM, nullptr, 1.f, scr, rot, NGW, lane);
        cvt_weight<0>(sb_w_out, 1024, 1024, 0, 1024, WB + WO_SB_O, 0, nullptr, nullptr, 1.f, scr, rot, NGW, lane);
        cvt_weight<3>(ret_w_in, 1024, 6144, 0, 1024, WB + WO_RT_QK, 0, n_mix_pre + 2 * DM, nullptr, 1.f, scr, rot, NGW, lane);
        cvt_weight<3>(ret_w_in, 1024, 6144, 1024, 1024, WB + WO_RT_QK, 1024, n_mix_pre + 2 * DM, nullptr, 0.0625f, scr, rot, NGW, lane);
        cvt_weight<0>(ret_w_in, 1024, 6144, 2048, 2048, WB + WO_RT_KV, 0, n_mix_pre + 2 * DM, nullptr, 1.f, scr, rot, NGW, lane);
        cvt_weight<0>(ret_w_in, 1024, 6144, 4096, 2048, WB + WO_RT_G, 0, n_mix_pre + 2 * DM, nullptr, 1.f, scr, rot, NGW, lane);
        cvt_weight<0>(ret_w_out, 2048, 1024, 0, 1024, WB + WO_RT_O, 0, nullptr, nullptr, 1.f, scr, rot, NGW, lane);
        for (int i = 0; i < DEPTH; ++i) {
            cvt_rows(xa_w_q + (size_t)i * 1048576, 1024, WB + WO_XA_Q + (size_t)i * 1048576, n_xa_pre + i * DM, 0.0625f * LOG2E, rot, NGW, lane);
            cvt_weight<0>(xa_w_kv + (size_t)i * 2097152, 1024, 2048, 0, 1024, WB + WO_XA_K + (size_t)i * 1048576, 0, n_mem + i * DM, nullptr, 1.f, scr, rot, NGW, lane);
            cvt_weight<0>(xa_w_kv + (size_t)i * 2097152, 1024, 2048, 1024, 1024, WB + WO_XA_V + (size_t)i * 1048576, 0, n_mem + i * DM, nullptr, 1.f, scr, rot, NGW, lane);
            cvt_weight<0>(xa_w_o + (size_t)i * 1048576, 1024, 1024, 0, 1024, WB + WO_XA_O + (size_t)i * 1048576, 0, nullptr, nullptr, 1.f, scr, rot, NGW, lane);
            cvt_weight<1>(ffn_w_in + (size_t)i * 1024 * 5632, 1024, 5632, 0, 2816, WB + WO_FF_IN + (size_t)i * 5632 * 1024, 0, n_ffn_pre + i * DM, nullptr, 1.f, scr, rot, NGW, lane);
            cvt_weight<2>(ffn_w_in + (size_t)i * 1024 * 5632, 1024, 5632, 2816, 2816, WB + WO_FF_IN + (size_t)i * 5632 * 1024, 0, n_ffn_pre + i * DM, nullptr, 1.f, scr, rot, NGW, lane);
            cvt_weight<0>(ffn_w_out + (size_t)i * 2816 * 1024, 2816, 1024, 0, 1024, WB + WO_FF_OUT + (size_t)i * 1024 * 2816, 0, nullptr, nullptr, 1.f, scr, rot, NGW, lane);
        }
        for (int e = bx * 512 + tid; e < SEQ * 128; e += G * 512) {
            const int t = e >> 7, d = e & 127;
            const double invf = exp2(-(double)d * (13.287712379549449 / 128.0));
            double rev = (double)t * invf * 0.15915494309189535; rev -= floor(rev);
            const float c = __builtin_amdgcn_cosf((float)rev), s = __builtin_amdgcn_sinf((float)rev);
            cosN[e] = c; sinN[e] = s; cosT[(size_t)d * SEQ + t] = c; sinT[(size_t)d * SEQ + t] = s;
        }
        for (int e = bx * 512 + tid; e < (int)(2 * MiB / 16); e += G * 512) ((u32x4*)(GAS u32x4*)(opq(ws) + WS_XCH))[e] = (u32x4){0u, 0u, 0u, 0u};
        rows_to_bf16(x_in, XB, RSTD, NTOK, nullptr, gw, NGW, lane);
        rows_to_bf16(mem, MEMB, MRSTD, NMEM, nullptr, gw, NGW, lane);
    }
    GRID_BAR();
    {
        pg8::Gemm g = pg8::mk_gemm(MEMB, WB + WO_XA_K, 1024, 1024, 1024, 16, 16, 0, 256 * 1024, 0, 30);
        pg8::StaticOrder S; S.init(16, 16, G, bx);
        pg8::EpiStore E{KMEM, 4096, MRSTD, nullptr, 30, 0};
        pg8::gemm_phase(lds, g, S, E);
    }
    {
        pg8::Gemm g = pg8::mk_gemm(MEMB, WB + WO_XA_V, 1024, 1024, 1024, 16, 16, 0, 256 * 1024, 0, 30);
        pg8::StaticOrder S; S.init(16, 16, G, bx);
        pg8::EpiStore E{VTMEM, 4096, MRSTD, nullptr, 30, 0};
        pg8::gemm_phase(lds, g, S, E);
    }
    GRID_BAR();

    unsigned ggen = 0;
    const bool same_xcd = __builtin_popcount((unsigned)__builtin_amdgcn_readfirstlane(xb_ld(ctl + CW_GRP + 64 * (16 + grp)))) == 1;
#define GROUP_BAR() grp_barrier(ctl + CW_GRP + 64 * grp, ggen, same_xcd)
#define SCRB ((unsigned char*)(opq(ws) + WS_MB + (size_t)grp * (40 * MiB)))
#define SCR_ROWS(off, ld) ((bf16_t*)(SCRB + (off)) - (size_t)grp * SEQ * (ld))
#define SCR_BAT(off, per) ((bf16_t*)(SCRB + (off)) - (size_t)grp * (per))
#define XCH_P(rowoff) ((unsigned long long*)(GAS unsigned long long*)(opq(ws) + WS_XCH) + (size_t)(rowoff) * 4)
static_assert(pg8::WGM * 4 * pg8::NXCD == 256, "fused post-norm exchange: with 256 workgroups, WGM * nN(=4) units per (XCD slice, round) must be exactly one 8-panel group, so that a row panel's four column tiles are always dealt in the SAME round (else the owners wait for each other across rounds: deadlock until the spin cap)");
#define FUSED_OUT(GDESC, NM, SUB, PBASE, ROWOFF, GPOST, OUT32) do { \
        pg8::Gemm g = pg8::mk_gemm GDESC; pg8::GroupOrder S; S.init(true, 16, 4, 4, 4, grp, wg16); \
        pg8::EpiNormRes E{XB + (size_t)(ROWOFF) * DM, XB + (size_t)(ROWOFF) * DM, (OUT32), RSTD + (size_t)(ROWOFF) * 4, (GPOST), XCH_P(ROWOFF), (unsigned)((SUB) + 1), lds + SMX_OFF}; \
        pg8::gemm_phase(lds, g, S, E); } while (0)
#pragma unroll 1
    for (int layer = 0; layer < DEPTH; ++layer) {
        const int kind = layer % 3, j = layer / 3;
        if (kind == 0) {
            bf16_t* DP = SCR_ROWS(0, 1024);
            pool_pre(XB, RSTD, n_mix_pre + layer * DM, DP, 64 * grp + wg16, 64 * grp + 64, 16, tid);
            GROUP_BAR();
            FUSED_OUT((DP, WB + WO_POOL + (size_t)j * 262144, 1024, 256, 256, 256, 4, 256, 65536, 0, 30), 256, layer * 3, 0, 0, n_mix_post + layer * DM, nullptr);
        } else if (kind == 1) {
            bf16_t* QK = SCR_ROWS(0, 2048); bf16_t* VT = SCR_BAT(16 * MiB, (size_t)1024 * LDT); bf16_t* AO = SCR_ROWS(25 * MiB, 1024);
            {
                pg8::Gemm g = pg8::mk_gemm(XB, WB + WO_SB_QK, 1024, 1024, 1024, 256, 8, 0, 256 * 1024, 0, 30);
                pg8::GroupOrder S; S.init(true, 16, 8, 4, 4, grp, wg16);
                pg8::EpiStore E{QK, 2048, RSTD, nullptr, 30, 0};
                pg8::gemm_phase(lds, g, S, E);
            }
            {
                pg8::Gemm g = pg8::mk_gemm(WB + WO_SB_V, XB, 1024, 1024, 1024, 4, 256, 0, 256 * 1024, 0, 30);
                pg8::GroupOrder S; S.init(false, 16, 4, 4, 4, grp, wg16);
                pg8::EpiStore E{VT, LDT, nullptr, RSTD, 4, (long)1024 * LDT};
                pg8::gemm_phase(lds, g, S, E);
            }
            GROUP_BAR();
            sb_attention(QK, VT, AO, lds, vcu, G, tid);
            GROUP_BAR();
            FUSED_OUT((AO, WB + WO_SB_O, 1024, 1024, 1024, 256, 4, 0, 256 * 1024, 0, 30), 256, layer * 3, 0, 0, n_mix_post + layer * DM, nullptr);
        } else {
            bf16_t* QKn = (bf16_t*)X; bf16_t* KVT = SCR_BAT(0, (size_t)2048 * LDR); bf16_t* RO = SCR_ROWS(17 * MiB, 2048);
            bf16_t* SC = (bf16_t*)(GAS bf16_t*)(opq(ws) + WS_SC); float* GNS = (float*)(GAS float*)(opq(ws) + WS_MEMB);
            {
                pg8::Gemm g = pg8::mk_gemm(XB, WB + WO_RT_QK, 1024, 1024, 1024, 256, 8, 0, 256 * 1024, 0, 30);
                pg8::GroupOrder S; S.init(true, 16, 8, 4, 4, grp, wg16);
                pg8::EpiRetQK E{QKn, 2048, RSTD, cosN, sinN};
                pg8::gemm_phase(lds, g, S, E);
            }
            {
                pg8::Gemm g = pg8::mk_gemm(WB + WO_RT_KV, XB, 1024, 1024, 1024, 8, 256, 0, 256 * 1024, 0, 30);
                pg8::GroupOrder S; S.init(false, 16, 8, 4, 4, grp, wg16);
                pg8::EpiRetKVT E{KVT, RSTD};
                pg8::gemm_phase(lds, g, S, E);
            }
            GROUP_BAR();
            ret_scores(QKn, SC, 256 * grp + wg16 * 8 + wave, 256 * grp + 256, 128, lane);
            GROUP_BAR();
            ret_scan(QKn, KVT, SC, RO, GNS, lds, vcu, G, tid);
            GROUP_BAR();
            {
                pg8::Gemm g = pg8::mk_gemm(XB, WB + WO_RT_G, 1024, 1024, 1024, 256, 8, 0, 256 * 1024, 0, 30);
                pg8::GroupOrder S; S.init(true, 16, 8, 4, 4, grp, wg16);
                pg8::EpiRetGate E{RO, 2048, RSTD, GNS, ret_gn};
                pg8::gemm_phase(lds, g, S, E);
            }
            GROUP_BAR();
            FUSED_OUT((RO, WB + WO_RT_O, 2048, 2048, 2048, 256, 4, 0, 256 * 2048, 0, 30), 256, layer * 3, 0, 0, n_mix_post + layer * DM, nullptr);
        }
        {
            bf16_t* P = SCR_ROWS(0, 1024); bf16_t* MT = SCR_BAT(34 * MiB, (size_t)1024 * 1024); bf16_t* NT = SCR_BAT(36 * MiB, (size_t)1024 * 1024);
            {
                pg8::Gemm g{KMEM + (size_t)layer * 1024, WB + WO_XA_Q + (size_t)layer * 1048576, 4096, 1024, 256, 64, 4, 2, 30, 256, (long)256 * 4096, 0, 0, 256, 0, (long)256 * 1024, 0};
                pg8::GroupOrder S; S.init(true, 4, 4, 4, 4, grp, wg16);
                pg8::EpiStore E{MT, 1024, nullptr, nullptr, 30, 0};
                pg8::gemm_phase(lds, g, S, E);
            }
            {
                pg8::Gemm g{WB + WO_XA_O + (size_t)layer * 1048576, VTMEM + (size_t)layer * 1024, 1024, 4096, 256, 4, 64, 30, 2, (long)256 * 1024, 0, 256, 0, 0, 0, 256, (long)256 * 4096};
                pg8::GroupOrder S; S.init(false, 4, 4, 4, 4, grp, wg16);
                pg8::EpiStore E{NT, 1024, nullptr, nullptr, 2, (long)1024 * 1024};
                pg8::gemm_phase(lds, g, S, E);
            }
            GROUP_BAR();
            {
                pg8::Gemm g = pg8::mk_gemm(XB, MT, 1024, 1024, 1024, 256, 4, 0, 256 * 1024, (long)1024 * 1024, 4);
                pg8::GroupOrder S; S.init(true, 16, 4, 4, 4, grp, wg16);
                pg8::EpiSoftmax E{P, 1024, (LAS float*)(lds + SMX_OFF), RSTD};
                pg8::gemm_phase(lds, g, S, E);
            }
            GROUP_BAR();
            FUSED_OUT((P, NT, 1024, 1024, 1024, 256, 4, 0, 256 * 1024, (long)1024 * 1024, 4), 256, layer * 3 + 1, 0, 0, n_xa_post + layer * DM, nullptr);
            GROUP_BAR();
        }
        {
            bf16_t* ACT = SCR_ROWS(0, DFF);
            {
                pg8::Gemm g = pg8::mk_gemm(XB, WB + WO_FF_IN + (size_t)layer * 5632 * 1024, 1024, 1024, 1024, 256, 22, 0, 256 * 1024, 0, 30);
                pg8::GroupOrder S; S.init(true, 16, 20, 4, 4, grp, wg16); S.tail0 = 20; S.rounds = 22;
                pg8::EpiSwiglu E{ACT, DFF, RSTD};
                pg8::gemm_phase(lds, g, S, E);
            }
            GROUP_BAR();
            FUSED_OUT((ACT, WB + WO_FF_OUT + (size_t)layer * 1024 * 2816, DFF, DFF, DFF, 256, 4, 0, (long)256 * DFF, 0, 30), 256, layer * 3 + 2, 0, 0, n_ffn_post + layer * DM, (layer == DEPTH - 1 ? X : nullptr));
            GROUP_BAR();
        }
    }
}

extern "C" void kernel_launch(void* const* d_in, const int* in_sizes, int n_in, void* d_out, int out_size, void* d_ws, size_t ws_size, hipStream_t stream) {
    static int grid = 0;
    if (grid == 0) {
        if (n_in != 21 || in_sizes[0] != NTOK * DM || out_size != NTOK * DM || ws_size < WS_END) {
            fprintf(stderr, "kernel_launch: unexpected problem (n_in %d, in0 %d, out %d, ws %zu, need %zu); nothing launched\n", n_in, n_in > 0 ? in_sizes[0] : -1, out_size, ws_size, (size_t)WS_END); grid = -1; return; }
        int dev = 0, cus = 0, per_cu = 0;
        if (hipGetDevice(&dev) != hipSuccess || hipDeviceGetAttribute(&cus, hipDeviceAttributeMultiprocessorCount, dev) != hipSuccess) { grid = -1; return; }
        if (hipFuncSetAttribute((const void*)fwd_kernel, hipFuncAttributeMaxDynamicSharedMemorySize, LDS_BYTES) != hipSuccess) { fprintf(stderr, "kernel_launch: hipFuncSetAttribute failed\n"); grid = -1; return; }
        if (hipOccupancyMaxActiveBlocksPerMultiprocessor(&per_cu, (const void*)fwd_kernel, 512, LDS_BYTES) != hipSuccess || per_cu < 1)
            fprintf(stderr, "kernel_launch: note: occupancy query reports %d workgroups per CU\n", per_cu);
        (void)hipGetLastError();
        if (cus != 256) { fprintf(stderr, "kernel_launch: built for 256 CUs (one 256-unit GEMM round per workgroup in the fused post-norm phases), device has %d; nothing launched\n", cus); grid = -1; return; }
        grid = cus;
    }
    if (grid < 0) return;
    if (hipMemsetAsync((char*)d_ws + WS_CTL, 0, CTL_ZERO_BYTES, stream) != hipSuccess) return;
    Args a{};
    for (int i = 0; i < 21; ++i) a.in[i] = (const float*)d_in[i];
    a.out = (float*)d_out; a.ws = (unsigned char*)d_ws;
    hipLaunchKernelGGL(fwd_kernel, dim3(grid), dim3(512), LDS_BYTES, stream, a);
}
```

```cpp
#include <hip/hip_runtime.h>
#include <cstdio>
#include <cstdint>

#define LAS __attribute__((address_space(3)))
#define GAS __attribute__((address_space(1)))
typedef unsigned short bf16_t;
typedef short bf16x8 __attribute__((ext_vector_type(8)));
typedef short bf16x4 __attribute__((ext_vector_type(4)));
typedef float f32x4 __attribute__((ext_vector_type(4)));
typedef float f32x2 __attribute__((ext_vector_type(2)));
typedef float f32x16 __attribute__((ext_vector_type(16)));
typedef unsigned u32x4 __attribute__((ext_vector_type(4)));
typedef unsigned u32x2 __attribute__((ext_vector_type(2)));
typedef __bf16 bf16x2_t __attribute__((ext_vector_type(2)));
#define DI __device__ __forceinline__

constexpr int NB = 16, SEQ = 4096, DM = 1024, NTOK = NB * SEQ, DEPTH = 4, DFF = 2816, MEML = 256, NMEM = NB * MEML;
constexpr int LDT = 4160;
constexpr int LDR = 4104;
constexpr float RMS_EPS = 1e-6f, GN_EPS = 1e-5f, LOG2E = 1.4426950408889634f;

constexpr size_t MiB = 1u << 20;
constexpr size_t WS_CTL = 0, CTL_ZERO_BYTES = 64 * 1024;
constexpr size_t WS_RSTD = 1 * MiB;
constexpr size_t WS_MRSTD = WS_RSTD + 256 * 1024;
constexpr size_t WS_ROPE = 2 * MiB;
constexpr size_t WS_MEMB = 10 * MiB;
constexpr size_t WS_KMEM = 18 * MiB;
constexpr size_t WS_VTMEM = 50 * MiB;
constexpr size_t WS_WB = 82 * MiB;
constexpr size_t WS_XB = 210 * MiB;
constexpr size_t WS_MB = 338 * MiB;
constexpr size_t WS_R = 466 * MiB;
constexpr size_t WS_XCH = WS_R + 520 * MiB;
constexpr size_t WS_SSQ = WS_XCH + 2 * MiB;
constexpr size_t WS_SC = WS_SSQ + 1 * MiB;
constexpr size_t WS_END = WS_SC + 32 * MiB;

constexpr size_t WO_POOL = 0;
constexpr size_t WO_SB_QK = WO_POOL + 2 * 262144;
constexpr size_t WO_SB_V = WO_SB_QK + 2048 * 1024;
constexpr size_t WO_SB_O = WO_SB_V + 1024 * 1024;
constexpr size_t WO_RT_QK = WO_SB_O + 1024 * 1024;
constexpr size_t WO_RT_KV = WO_RT_QK + 2048 * 1024;
constexpr size_t WO_RT_G = WO_RT_KV + 3072 * 1024;
constexpr size_t WO_RT_O = WO_RT_G + 2048 * 1024;
constexpr size_t WO_XA_Q = WO_RT_O + 1024 * 2048;
constexpr size_t WO_XA_K = WO_XA_Q + 4 * 1024 * 1024;
constexpr size_t WO_XA_V = WO_XA_K + 4 * 1024 * 1024;
constexpr size_t WO_XA_O = WO_XA_V + 4 * 1024 * 1024;
constexpr size_t WO_FF_IN = WO_XA_O + 4 * 1024 * 1024;
constexpr size_t WO_FF_OUT = WO_FF_IN + 4 * (size_t)5632 * 1024;
constexpr size_t WO_END = WO_FF_OUT + 4 * (size_t)1024 * 2816;
static_assert(WO_END * 2 <= 128 * MiB, "weights fit");

constexpr int CW_BAR = 4096;
constexpr int CW_GRP = 8192;

constexpr int RING_BYTES = 131072;
constexpr int SMX_OFF = RING_BYTES;
constexpr int MISC_OFF = RING_BYTES + 16384;
constexpr int RT_OFF = 149504;
constexpr int LDS_BYTES = 157696;

DI unsigned cvtpk(float lo, float hi) { f32x2 v = {lo, hi}; bf16x2_t b = __builtin_convertvector(v, bf16x2_t); return __builtin_bit_cast(unsigned, b); }
DI float bf2f(unsigned short b) { return __uint_as_float(((unsigned)b) << 16); }
DI float bflo(unsigned w) { return __uint_as_float(w << 16); }
DI float bfhi(unsigned w) { return __uint_as_float(w & 0xffff0000u); }
DI float xsum16(float v) { const auto r = __builtin_amdgcn_permlane16_swap(__float_as_uint(v), __float_as_uint(v), false, false); return __uint_as_float(r[0]) + __uint_as_float(r[1]); }
DI float xsum32(float v) { const auto r = __builtin_amdgcn_permlane32_swap(__float_as_uint(v), __float_as_uint(v), false, false); return __uint_as_float(r[0]) + __uint_as_float(r[1]); }
DI float xmax16(float v) { const auto r = __builtin_amdgcn_permlane16_swap(__float_as_uint(v), __float_as_uint(v), false, false); return fmaxf(__uint_as_float(r[0]), __uint_as_float(r[1])); }
DI float xmax32(float v) { const auto r = __builtin_amdgcn_permlane32_swap(__float_as_uint(v), __float_as_uint(v), false, false); return fmaxf(__uint_as_float(r[0]), __uint_as_float(r[1])); }
DI float xchg32(float v, int upper) { const auto r = __builtin_amdgcn_permlane32_swap(__float_as_uint(v), __float_as_uint(v), false, false); return __uint_as_float(upper ? r[0] : r[1]); }
DI float rowsum16(float v) {
    v += __uint_as_float(__builtin_amdgcn_update_dpp(0, __float_as_uint(v), 0x128, 0xf, 0xf, false));
    v += __uint_as_float(__builtin_amdgcn_update_dpp(0, __float_as_uint(v), 0x124, 0xf, 0xf, false));
    v += __uint_as_float(__builtin_amdgcn_update_dpp(0, __float_as_uint(v), 0x122, 0xf, 0xf, false));
    v += __uint_as_float(__builtin_amdgcn_update_dpp(0, __float_as_uint(v), 0x121, 0xf, 0xf, false));
    return v; }
DI float wave_sum(float v) { return xsum32(xsum16(rowsum16(v))); }
DI float ex2(float x) { return __builtin_amdgcn_exp2f(x); }
DI float lg2(float x) { return __builtin_amdgcn_logf(x); }
DI float rstd_of(const float* ssq, int row) { const f32x4 p = *(const f32x4*)(ssq + (size_t)row * 4); return __builtin_amdgcn_rsqf(((p[0] + p[1]) + (p[2] + p[3])) * (1.0f / DM) + RMS_EPS); }
DI float rstd_q(const f32x4 p) { return __builtin_amdgcn_rsqf(((p[0] + p[1]) + (p[2] + p[3])) * (1.0f / DM) + RMS_EPS); }
DI float silu(float g) { return g * __builtin_amdgcn_rcpf(1.0f + ex2(-g * LOG2E)); }
#define LDS_WAIT() asm volatile("s_waitcnt lgkmcnt(0)" ::: "memory")
#define VM_WAIT() asm volatile("s_waitcnt vmcnt(0)" ::: "memory")

namespace pg8 {
constexpr int BM = 256, BK = 64, HALF = 128, HTB = HALF * BK * 2, STAGE_BYTES = 8 * HTB, NXCD = 8, WGM = 8;
DI int lds_byte(int r, int c) { const int st = (r >> 4) * 2 + (c >> 5), rr = r & 15, cc = c & 31, ob = rr * 64 + cc * 2; return st * 1024 + (ob ^ (((ob >> 9) & 1) << 5)); }
DI void stage_rc(int b, int& R, int& C) { const int st = b / 1024, sb = b % 1024, swz = sb ^ (((sb >> 9) & 1) << 5); R = (st >> 1) * 16 + swz / 64; C = (st & 1) * 32 + (swz % 64) / 2; }
DI int perm32(int rho) { const int n = rho >> 4, i = rho & 15; return 8 * (i >> 2) + 4 * n + (i & 3); }
struct Unit { int pm, pn; };
struct Gemm { const bf16_t* A; const bf16_t* B; int lda, ldb, K, nM, nN, msh, nsh; long a_ml, a_mh, a_nl, a_nh, b_ml, b_mh, b_nl, b_nh;
    DI const char* aptr(int pm, int pn) const { return (const char*)(A + (size_t)(pm & ((1 << msh) - 1)) * a_ml + (size_t)(pm >> msh) * a_mh + (size_t)(pn & ((1 << nsh) - 1)) * a_nl + (size_t)(pn >> nsh) * a_nh); }
    DI const char* bptr(int pm, int pn) const { return (const char*)(B + (size_t)(pm & ((1 << msh) - 1)) * b_ml + (size_t)(pm >> msh) * b_mh + (size_t)(pn & ((1 << nsh) - 1)) * b_nl + (size_t)(pn >> nsh) * b_nh); } };
DI Gemm mk_gemm(const bf16_t* A, const bf16_t* B, int lda, int ldb, int K, int nM, int nN, long a_pn, long b_pn, long b_z, int zshift) {
    return Gemm{A, B, lda, ldb, K, nM, nN, zshift, 30, 256L * lda, (256L * lda) << zshift, a_pn, 0, 0, b_z, b_pn, 0}; }
struct StaticOrder {
    int nM, nN, nwg, G, c;
    DI void init(int nM_, int nN_, int G_, int c_) { nM = nM_; nN = nN_; nwg = nM * nN; G = G_; c = c_; }
    DI bool next(int i, Unit& u) const {
        const long L = (long)i * G + c; if (L >= nwg) return false;
        int wgid = (int)L; { const int q = nwg / NXCD, r = nwg % NXCD, xcd = wgid % NXCD, off = wgid / NXCD; wgid = (xcd < r ? xcd * (q + 1) : r * (q + 1) + (xcd - r) * q) + off; }
        const int nig = WGM * nN, gid = wgid / nig, fm = gid * WGM, gsz = (nM - fm) < WGM ? (nM - fm) : WGM;
        u.pm = fm + ((wgid % nig) % gsz); u.pn = (wgid % nig) / gsz; return true;
    }
};

template <class Epi, class Sched>
DI void gemm_phase(LAS unsigned char* lds, const Gemm g, const Sched& S, const Epi& E) {
    int tid = threadIdx.x; asm volatile("" : "+v"(tid));
    const int wid = __builtin_amdgcn_readfirstlane(tid >> 6), lane = tid & 63, wr = wid >> 2, wc = wid & 3, fr = lane & 15, fq = lane >> 4;
    const int K = g.K, nt = K / BK;
    unsigned voffA[2], voffB[2];
#pragma unroll
    for (int i = 0; i < 2; ++i) { int R, C; stage_rc(tid * 16 + i * 8192, R, C); const int Rb = (R & ~31) + perm32(R & 31);
        voffA[i] = (unsigned)(R * g.lda + C) * 2u; voffB[i] = (unsigned)(Rb * g.ldb + C) * 2u; }
    const size_t kstep = (size_t)(BK * 2);
    const size_t hstepA = (size_t)HALF * g.lda * 2, hstepB = (size_t)HALF * g.ldb * 2;
    const unsigned ldsw = (unsigned)wid * 1024u;
    const int aoff = lds_byte(wr * 64 + fr, fq * 8), boff = lds_byte(wc * 32 + fr, fq * 8);
#define PG8_SA(b, h) (((b) * 2 + (h)) * HTB)
#define PG8_SB(b, h) ((4 + (b) * 2 + (h)) * HTB)
#define PG8_STAGE(bufoff, gbase, voff) do { _Pragma("unroll") for (int _i = 0; _i < 2; ++_i) \
        __builtin_amdgcn_global_load_lds((const unsigned*)((const char*)(gbase) + (voff)[_i]), (LAS unsigned*)(lds + (bufoff) + ldsw + _i * 8192), 16, 0, 0); } while (0)
#define PG8_LDA(dst, b, h) do { _Pragma("unroll") for (int m = 0; m < 4; ++m) _Pragma("unroll") for (int k = 0; k < 2; ++k) dst[m][k] = *(const LAS bf16x8*)(lds + PG8_SA(b, h) + aoff + m * 2048 + k * 1024); } while (0)
#define PG8_LDB(dst, b, h) do { _Pragma("unroll") for (int n = 0; n < 2; ++n) _Pragma("unroll") for (int k = 0; k < 2; ++k) dst[n][k] = *(const LAS bf16x8*)(lds + PG8_SB(b, h) + boff + n * 2048 + k * 1024); } while (0)
#define PG8_MMA(ai, bj, At, Bt) do { __builtin_amdgcn_s_setprio(1); _Pragma("unroll") for (int m = 0; m < 4; ++m) _Pragma("unroll") for (int n = 0; n < 2; ++n) _Pragma("unroll") for (int k = 0; k < 2; ++k) \
        acc[ai][bj][m][n] = __builtin_amdgcn_mfma_f32_16x16x32_bf16(Bt[n][k], At[m][k], acc[ai][bj][m][n], 0, 0, 0); __builtin_amdgcn_s_setprio(0); } while (0)
#define PG8_WAIT_V(n) asm volatile("s_waitcnt vmcnt(" #n ")" ::: "memory")
#define PG8_WAIT_L(n) asm volatile("s_waitcnt lgkmcnt(" #n ")" ::: "memory")
#define PG8_BAR __builtin_amdgcn_s_barrier()
#define PG8_SCHED __builtin_amdgcn_sched_barrier(0)
    Unit cur, nxt; int ui = 0;
    if (!S.next(0, cur)) return;
    f32x4 acc[2][2][4][2];
#pragma unroll
    for (int a = 0; a < 2; ++a)
#pragma unroll
        for (int b = 0; b < 2; ++b)
#pragma unroll
            for (int m = 0; m < 4; ++m)
#pragma unroll
                for (int n = 0; n < 2; ++n) acc[a][b][m][n] = (f32x4){0.f, 0.f, 0.f, 0.f};
    bf16x8 At[4][2], B0[2][2], B1[2][2];
    const char* cA = g.aptr(cur.pm, cur.pn);
    const char* cB = g.bptr(cur.pm, cur.pn);
    LAS float* rtab = (LAS float*)(lds + RT_OFF);
    const float* rsp = nullptr;
    if constexpr (Epi::ROWSTAT) { rsp = E.rs ? E.rs : (const float*)g.A;
        __builtin_amdgcn_global_load_lds((const unsigned*)(rsp + (size_t)(cur.pm * BM + (wid & 3) * 64 + lane) * 4), (LAS unsigned*)(rtab + (wid & 3) * 256), 16, 0, 0); }
    PG8_STAGE(PG8_SB(0, 0), cB, voffB); PG8_STAGE(PG8_SB(0, 1), cB + hstepB, voffB); PG8_STAGE(PG8_SA(0, 0), cA, voffA); PG8_STAGE(PG8_SA(0, 1), cA + hstepA, voffA);
    if (wr == 1) PG8_BAR;
    PG8_WAIT_V(2); PG8_BAR;
    PG8_STAGE(PG8_SB(1, 0), cB + kstep, voffB); PG8_STAGE(PG8_SA(1, 0), cA + kstep, voffA); PG8_STAGE(PG8_SB(1, 1), cB + hstepB + kstep, voffB);
    PG8_WAIT_V(6); PG8_BAR;
    for (;;) {
        const bool has_next = S.next(ui + 1, nxt);
        const char* nA = has_next ? g.aptr(nxt.pm, nxt.pn) : cA;
        const char* nB = has_next ? g.bptr(nxt.pm, nxt.pn) : cB;
        for (int t = 0; t < nt; t += 2) {
            const bool last = (t == nt - 2);
            const char* a1 = cA + (size_t)(t + 1) * kstep;
            const char* a2 = last ? nA : cA + (size_t)(t + 2) * kstep; const char* b2 = last ? nB : cB + (size_t)(t + 2) * kstep;
            const char* a3 = a2 + kstep; const char* b3 = b2 + kstep;
            PG8_LDB(B0, 0, 0); PG8_LDB(B1, 0, 1); PG8_SCHED; PG8_LDA(At, 0, 0); PG8_STAGE(PG8_SA(1, 1), a1 + hstepA, voffA);
            PG8_WAIT_V(8); PG8_WAIT_L(0); PG8_BAR; PG8_MMA(0, 0, At, B0); PG8_MMA(0, 1, At, B1); PG8_BAR; PG8_SCHED;
            PG8_LDA(At, 0, 1); PG8_STAGE(PG8_SB(0, 0), b2, voffB); PG8_STAGE(PG8_SB(0, 1), b2 + hstepB, voffB); PG8_STAGE(PG8_SA(0, 0), a2, voffA);
            PG8_WAIT_V(8); PG8_WAIT_L(0); PG8_BAR; PG8_MMA(1, 0, At, B0); PG8_MMA(1, 1, At, B1); PG8_BAR; PG8_SCHED;
            PG8_LDB(B0, 1, 0); PG8_LDB(B1, 1, 1); PG8_SCHED; PG8_LDA(At, 1, 0); PG8_STAGE(PG8_SA(0, 1), a2 + hstepA, voffA);
            PG8_WAIT_V(8); PG8_WAIT_L(0); PG8_BAR; PG8_MMA(0, 0, At, B0); PG8_MMA(0, 1, At, B1); PG8_BAR; PG8_SCHED;
            PG8_LDA(At, 1, 1); PG8_STAGE(PG8_SB(1, 0), b3, voffB); PG8_STAGE(PG8_SB(1, 1), b3 + hstepB, voffB); PG8_STAGE(PG8_SA(1, 0), a3, voffA);
            PG8_WAIT_V(8); PG8_WAIT_L(0); PG8_BAR; PG8_MMA(1, 0, At, B0); PG8_MMA(1, 1, At, B1); PG8_BAR; PG8_SCHED;
        }
        if (wr == 0) PG8_BAR;
        if constexpr (!Epi::AFTER_DRAIN) { int fr_ = fr, fq_ = fq; asm volatile("" : "+v"(fr_), "+v"(fq_));
          if constexpr (Epi::ROWSTAT) __builtin_amdgcn_global_load_lds((const unsigned*)(rsp + (size_t)((has_next ? nxt.pm : cur.pm) * BM + (wid & 3) * 64 + lane) * 4), (LAS unsigned*)(rtab + ((ui + 1) & 1) * 1024 + (wid & 3) * 256), 16, 0, 0);
          E(acc, cur, wr, wc, fr_, fq_, rtab + (ui & 1) * 1024); }
        if (!has_next) break;
#pragma unroll
        for (int a = 0; a < 2; ++a)
#pragma unroll
            for (int b = 0; b < 2; ++b)
#pragma unroll
                for (int m = 0; m < 4; ++m)
#pragma unroll
                    for (int n = 0; n < 2; ++n) acc[a][b][m][n] = (f32x4){0.f, 0.f, 0.f, 0.f};
        cur = nxt; cA = nA; cB = nB; ++ui;
        if (wr == 1) PG8_BAR;
    }
    PG8_WAIT_V(0);
    PG8_BAR;
    if constexpr (Epi::AFTER_DRAIN) { int fr_ = fr, fq_ = fq; asm volatile("" : "+v"(fr_), "+v"(fq_)); E.fused(acc, cur, wr, wc, fr_, fq_, lds, wid, lane); }
#undef PG8_SA
#undef PG8_SB
#undef PG8_STAGE
#undef PG8_LDA
#undef PG8_LDB
#undef PG8_MMA
#undef PG8_WAIT_V
#undef PG8_WAIT_L
#undef PG8_BAR
#undef PG8_SCHED
}

struct RoundOrder : StaticOrder { int round; DI bool next(int i, Unit& u) const { return i == 0 ? StaticOrder::next(round, u) : false; } };
struct GroupOrder {
    int grp, w, TT, PB, TB, ntb, rounds; bool tokM; int tail0 = 1 << 30;
    DI void init(bool tokM_, int TT_, int nOther, int PB_, int TB_, int grp_, int w_) { tokM = tokM_; TT = TT_; PB = PB_; TB = TB_; ntb = nOther / TB_; rounds = TT_ * nOther / 16; grp = grp_; w = w_; }
    DI bool next(int i, Unit& u) const {
        if (i >= rounds) return false;
        if (i >= tail0) { const int bt8 = TT * grp + (i - tail0) * 8 + (w & 7), ot2 = ntb * TB + (w >> 3); if (tokM) { u.pm = bt8; u.pn = ot2; } else { u.pm = ot2; u.pn = bt8; } return true; }
        const int pb = i / ntb, tb = i - pb * ntb, bt = TT * grp + pb * PB + (w % PB), ot = tb * TB + (w / PB);
        if (tokM) { u.pm = bt; u.pn = ot; } else { u.pm = ot; u.pn = bt; }
        return true; }
};
typedef f32x4 Acc[2][2][4][2];

struct EpiStore {
    static constexpr bool AFTER_DRAIN = false; static constexpr bool ROWSTAT = true;
    bf16_t* O; long ldc; const float* rs; const float* cs; int csh; long cbs;
    DI void operator()(const Acc& acc, const Unit& u, int wr, int wc, int fr, int fq, const LAS float* rt) const {
        const int row0 = u.pm * BM + wr * 64 + fr;
        const long cbase = (long)(u.pn >> csh) * cbs + (long)(u.pn & ((1 << csh) - 1)) * 256 + wc * 32 + 8 * fq;
        float pr[2][4];
        if (rs) {
#pragma unroll
            for (int ai = 0; ai < 2; ++ai)
#pragma unroll
                for (int m = 0; m < 4; ++m) pr[ai][m] = rstd_q(*(const LAS f32x4*)(rt + 4 * (ai * HALF + wr * 64 + m * 16 + fr))); }
        float csv[2][8];
#pragma unroll
        for (int bj = 0; bj < 2; ++bj) {
            if (cs) {
#pragma unroll
                for (int k = 0; k < 8; ++k) csv[bj][k] = rstd_of(cs, u.pn * BM + bj * HALF + wc * 32 + 8 * fq + k); }
            else {
#pragma unroll
                for (int k = 0; k < 8; ++k) csv[bj][k] = 1.f; }
        }
        asm volatile("" ::: "memory");
#pragma unroll
        for (int ai = 0; ai < 2; ++ai)
#pragma unroll
            for (int m = 0; m < 4; ++m) { const int row = row0 + ai * HALF + m * 16; const float r = rs ? pr[ai][m] : 1.f;
                bf16_t* rowp = O + (size_t)row * ldc + cbase;
#pragma unroll
                for (int bj = 0; bj < 2; ++bj) { const f32x4 v0 = acc[ai][bj][m][0], v1 = acc[ai][bj][m][1];
                    u32x4 w; w.x = cvtpk(v0[0] * r * csv[bj][0], v0[1] * r * csv[bj][1]); w.y = cvtpk(v0[2] * r * csv[bj][2], v0[3] * r * csv[bj][3]);
                    w.z = cvtpk(v1[0] * r * csv[bj][4], v1[1] * r * csv[bj][5]); w.w = cvtpk(v1[2] * r * csv[bj][6], v1[3] * r * csv[bj][7]);
                    *(u32x4*)(rowp + bj * HALF) = w; } }
    }
};
struct EpiSwiglu {
    static constexpr bool AFTER_DRAIN = false; static constexpr bool ROWSTAT = true;
    bf16_t* O; long ldc; const float* rs;
    DI void operator()(const Acc& acc, const Unit& u, int wr, int wc, int fr, int fq, const LAS float* rt) const {
        const int row0 = u.pm * BM + wr * 64 + fr; const int col = u.pn * 128 + wc * 32 + 8 * fq;
        float pr[2][4];
#pragma unroll
        for (int ai = 0; ai < 2; ++ai)
#pragma unroll
            for (int m = 0; m < 4; ++m) pr[ai][m] = rstd_q(*(const LAS f32x4*)(rt + 4 * (ai * HALF + wr * 64 + m * 16 + fr)));
        asm volatile("" ::: "memory");
#pragma unroll
        for (int ai = 0; ai < 2; ++ai)
#pragma unroll
            for (int m = 0; m < 4; ++m) { const int row = row0 + ai * HALF + m * 16; const float r = pr[ai][m]; const float rc = r * -LOG2E, r2i = __builtin_amdgcn_rcpf(r * r);
                const f32x4 g0 = acc[ai][0][m][0], g1 = acc[ai][0][m][1], u0 = acc[ai][1][m][0], u1 = acc[ai][1][m][1];
                const f32x4 x0 = g0 * rc, x1 = g1 * rc, p0 = g0 * u0, p1 = g1 * u1;
                f32x4 e0, e1;
#pragma unroll
                for (int i = 0; i < 4; ++i) { e0[i] = ex2(x0[i]); e1[i] = ex2(x1[i]); }
                const f32x4 d0 = e0 * r2i + r2i, d1 = e1 * r2i + r2i;
                f32x4 q0, q1;
#pragma unroll
                for (int i = 0; i < 4; ++i) { q0[i] = __builtin_amdgcn_rcpf(d0[i]); q1[i] = __builtin_amdgcn_rcpf(d1[i]); }
                const f32x4 o0 = p0 * q0, o1 = p1 * q1;
                u32x4 w; w.x = cvtpk(o0[0], o0[1]); w.y = cvtpk(o0[2], o0[3]); w.z = cvtpk(o1[0], o1[1]); w.w = cvtpk(o1[2], o1[3]);
                *(u32x4*)(O + (size_t)row * ldc + col) = w; }
    }
};
struct EpiSoftmax {
    static constexpr bool AFTER_DRAIN = false; static constexpr bool ROWSTAT = true;
    bf16_t* O; long ldc; LAS float* tab; const float* rs;
    DI void operator()(Acc& acc, const Unit& u, int wr, int wc, int fr, int fq, const LAS float* rt) const {
        float mw[2][4];
        float pr[2][4];
        if (rs) {
#pragma unroll
            for (int ai = 0; ai < 2; ++ai)
#pragma unroll
                for (int m = 0; m < 4; ++m) pr[ai][m] = rstd_q(*(const LAS f32x4*)(rt + 4 * (ai * HALF + wr * 64 + m * 16 + fr))); }
        asm volatile("" ::: "memory");
#pragma unroll
        for (int ai = 0; ai < 2; ++ai)
#pragma unroll
            for (int m = 0; m < 4; ++m) {
                const float rsc = rs ? pr[ai][m] : 1.f;
                float mx = -INFINITY;
#pragma unroll
                for (int bj = 0; bj < 2; ++bj)
#pragma unroll
                    for (int n = 0; n < 2; ++n) { const f32x4 v = acc[ai][bj][m][n]; mx = fmaxf(fmaxf(mx, fmaxf(v[0], v[1])), fmaxf(v[2], v[3])); }
                mx = xmax32(xmax16(mx)) * rsc;
                const float nm = -mx;
                float s = 0.f;
#pragma unroll
                for (int bj = 0; bj < 2; ++bj)
#pragma unroll
                    for (int n = 0; n < 2; ++n)
#pragma unroll
                        for (int i = 0; i < 4; ++i) { const float p = ex2(__builtin_fmaf(acc[ai][bj][m][n][i], rsc, nm)); acc[ai][bj][m][n][i] = p; s += p; }
                s = xsum32(xsum16(s));
                mw[ai][m] = mx;
                const int r = ai * HALF + wr * 64 + m * 16 + fr;
                if (fq == 0) { tab[(r * 4 + wc) * 2] = mx; tab[(r * 4 + wc) * 2 + 1] = s; }
            }
        LDS_WAIT(); __builtin_amdgcn_s_barrier(); asm volatile("" ::: "memory");
        const int row0 = u.pm * BM + wr * 64 + fr; const int col = u.pn * BM + wc * 32 + 8 * fq;
#pragma unroll
        for (int ai = 0; ai < 2; ++ai)
#pragma unroll
            for (int m = 0; m < 4; ++m) {
                const int r = ai * HALF + wr * 64 + m * 16 + fr;
                const f32x4 t0 = *(const LAS f32x4*)(tab + r * 8), t1 = *(const LAS f32x4*)(tab + r * 8 + 4);
                const float M = fmaxf(fmaxf(t0[0], t0[2]), fmaxf(t1[0], t1[2]));
                const float L = t0[1] * ex2(t0[0] - M) + t0[3] * ex2(t0[2] - M) + t1[1] * ex2(t1[0] - M) + t1[3] * ex2(t1[2] - M);
                const float f = ex2(mw[ai][m] - M) * __builtin_amdgcn_rcpf(L);
                bf16_t* rowp = O + (size_t)(row0 + ai * HALF + m * 16) * ldc + col;
#pragma unroll
                for (int bj = 0; bj < 2; ++bj) { const f32x4 v0 = acc[ai][bj][m][0] * f, v1 = acc[ai][bj][m][1] * f;
                    u32x4 w; w.x = cvtpk(v0[0], v0[1]); w.y = cvtpk(v0[2], v0[3]); w.z = cvtpk(v1[0], v1[1]); w.w = cvtpk(v1[2], v1[3]);
                    *(u32x4*)(rowp + bj * HALF) = w; }
            }
    }
};
struct EpiRetQK {
    static constexpr bool AFTER_DRAIN = false; static constexpr bool ROWSTAT = true;
    bf16_t* O; long ldc; const float* rs; const float* cosN; const float* sinN;
    DI void operator()(const Acc& acc, const Unit& u, int wr, int wc, int fr, int fq, const LAS float* rt) const {
        const int row0 = u.pm * BM + wr * 64 + fr; const int d0 = wc * 32 + 8 * fq, dt0 = wc * 32 + 4 * fq;
        const float lg = lg2(1.0f - ex2(-5.0f - (float)(u.pn & 3))) * (u.pn < 4 ? 1.f : -1.f);
        float pq[2]; f32x4 cc[2][2], ss[2][2];
#define RQK_LOAD(slot, ai_, m_) do { const int row_ = row0 + (ai_) * HALF + (m_) * 16; const int t_ = row_ & (SEQ - 1); pq[slot] = rstd_q(*(const LAS f32x4*)(rt + 4 * ((ai_) * HALF + wr * 64 + (m_) * 16 + fr))); \
            cc[slot][0] = *(const f32x4*)(cosN + (size_t)t_ * 128 + dt0); cc[slot][1] = *(const f32x4*)(cosN + (size_t)t_ * 128 + dt0 + 16); \
            ss[slot][0] = *(const f32x4*)(sinN + (size_t)t_ * 128 + dt0); ss[slot][1] = *(const f32x4*)(sinN + (size_t)t_ * 128 + dt0 + 16); } while (0)
        RQK_LOAD(0, 0, 0);
#pragma unroll
        for (int ai = 0; ai < 2; ++ai)
#pragma unroll
            for (int m = 0; m < 4; ++m) { const int g = ai * 4 + m, sl = g & 1; const int row = row0 + ai * HALF + m * 16; const int t = row & (SEQ - 1);
                if (g < 7) RQK_LOAD(sl ^ 1, (g + 1) >> 2, (g + 1) & 3);
                asm volatile("" ::: "memory");
                const float r = pq[sl] * ex2((float)(t & 63) * lg);
                bf16_t* rowp = O + (size_t)row * ldc + u.pn * BM + d0;
                float o1[8], o2[8];
#pragma unroll
                for (int n = 0; n < 2; ++n) { const f32x4 c = cc[sl][n], sn = ss[sl][n];
#pragma unroll
                    for (int i = 0; i < 4; ++i) { const float x1 = acc[ai][0][m][n][i] * r, x2 = acc[ai][1][m][n][i] * r; o1[4 * n + i] = x1 * c[i] - x2 * sn[i]; o2[4 * n + i] = x1 * sn[i] + x2 * c[i]; } }
                const bool hsw = (u.pn >= 4) && ((t & 8) != 0);
                u32x4 w; w.x = cvtpk(o1[0], o1[1]); w.y = cvtpk(o1[2], o1[3]); w.z = cvtpk(o1[4], o1[5]); w.w = cvtpk(o1[6], o1[7]); if (hsw) w = (u32x4){w.z, w.w, w.x, w.y}; *(u32x4*)(rowp) = w;
                w.x = cvtpk(o2[0], o2[1]); w.y = cvtpk(o2[2], o2[3]); w.z = cvtpk(o2[4], o2[5]); w.w = cvtpk(o2[6], o2[7]); if (hsw) w = (u32x4){w.z, w.w, w.x, w.y}; *(u32x4*)(rowp + HALF) = w;
                asm volatile("" ::: "memory"); }
#undef RQK_LOAD
    }
};
struct EpiRetKVT {
    static constexpr bool AFTER_DRAIN = false; static constexpr bool ROWSTAT = false;
    bf16_t* O; const float* cs;
    DI void operator()(const Acc& acc, const Unit& u, int wr, int wc, int fr, int fq, const LAS float* rt) const {
        const int rl0 = wr * 64 + fr;
        const int tcol = (u.pn & 15) * 256 + wc * 32 + 8 * fq;
        bf16_t* base = O + (size_t)(u.pn >> 4) * 2048 * LDR + (size_t)(u.pm * BM) * LDR + tcol;
        float csv[2][8];
#pragma unroll
        for (int bj = 0; bj < 2; ++bj)
#pragma unroll
            for (int k = 0; k < 8; ++k) csv[bj][k] = rstd_of(cs, u.pn * BM + bj * HALF + wc * 32 + 8 * fq + k);
#pragma unroll
        for (int ai = 0; ai < 2; ++ai)
#pragma unroll
            for (int m = 0; m < 4; ++m) { bf16_t* rowp = base + (size_t)(rl0 + ai * HALF + m * 16) * LDR;
#pragma unroll
                for (int bj = 0; bj < 2; ++bj) { const f32x4 v0 = acc[ai][bj][m][0], v1 = acc[ai][bj][m][1];
                    u32x4 w; w.x = cvtpk(v0[0] * csv[bj][0], v0[1] * csv[bj][1]); w.y = cvtpk(v0[2] * csv[bj][2], v0[3] * csv[bj][3]);
                    w.z = cvtpk(v1[0] * csv[bj][4], v1[1] * csv[bj][5]); w.w = cvtpk(v1[2] * csv[bj][6], v1[3] * csv[bj][7]);
                    *(u32x4*)(rowp + bj * HALF) = w; } }
    }
};
struct EpiRetGate {
    static constexpr bool AFTER_DRAIN = false; static constexpr bool ROWSTAT = true;
    bf16_t* Y; long ldc; const float* rs; const float* gns; const float* gain;
    DI void operator()(const Acc& acc, const Unit& u, int wr, int wc, int fr, int fq, const LAS float* rt) const {
        const int row0 = u.pm * BM + wr * 64 + fr; const int col = u.pn * BM + wc * 32 + 8 * fq;
        float gv[2][8];
#pragma unroll
        for (int bj = 0; bj < 2; ++bj) { const f32x4 a = *(const f32x4*)(gain + col + bj * HALF), b = *(const f32x4*)(gain + col + bj * HALF + 4);
            gv[bj][0] = a[0]; gv[bj][1] = a[1]; gv[bj][2] = a[2]; gv[bj][3] = a[3]; gv[bj][4] = b[0]; gv[bj][5] = b[1]; gv[bj][6] = b[2]; gv[bj][7] = b[3]; }
        float pq[2]; f32x4 g0[2], g1[2]; u32x4 on[2][2];
#define RG_LOAD(slot, ai_, m_) do { const int row_ = row0 + (ai_) * HALF + (m_) * 16; pq[slot] = rstd_q(*(const LAS f32x4*)(rt + 4 * ((ai_) * HALF + wr * 64 + (m_) * 16 + fr))); \
            g0[slot] = *(const f32x4*)(gns + (size_t)row_ * 32 + (u.pn >> 1) * 8); g1[slot] = *(const f32x4*)(gns + (size_t)row_ * 32 + (u.pn >> 1) * 8 + 4); \
            on[slot][0] = *(const u32x4*)(Y + (size_t)row_ * ldc + col); on[slot][1] = *(const u32x4*)(Y + (size_t)row_ * ldc + col + HALF); } while (0)
        RG_LOAD(0, 0, 0);
#pragma unroll
        for (int ai = 0; ai < 2; ++ai)
#pragma unroll
            for (int m = 0; m < 4; ++m) { const int g = ai * 4 + m, sl = g & 1; const int row = row0 + ai * HALF + m * 16;
                if (g < 7) RG_LOAD(sl ^ 1, (g + 1) >> 2, (g + 1) & 3);
                asm volatile("" ::: "memory");
                const float r = pq[sl]; const f32x4 p0 = g0[sl], p1 = g1[sl];
                const float mu = ((p0[0] + p0[2]) + (p1[0] + p1[2])) * (1.0f / 512.0f), ex2v = ((p0[1] + p0[3]) + (p1[1] + p1[3])) * (1.0f / 512.0f);
                const float gr = __builtin_amdgcn_rsqf(fmaxf(ex2v - mu * mu, 0.f) + GN_EPS);
                bf16_t* rowp = Y + (size_t)row * ldc + col;
#pragma unroll
                for (int bj = 0; bj < 2; ++bj) { const u32x4 onv = on[sl][bj]; const f32x4 v0 = acc[ai][bj][m][0], v1 = acc[ai][bj][m][1];
                    u32x4 w;
                    w.x = cvtpk(silu(v0[0] * r) * (bflo(onv.x) - mu) * gr * gv[bj][0], silu(v0[1] * r) * (bfhi(onv.x) - mu) * gr * gv[bj][1]); w.y = cvtpk(silu(v0[2] * r) * (bflo(onv.y) - mu) * gr * gv[bj][2], silu(v0[3] * r) * (bfhi(onv.y) - mu) * gr * gv[bj][3]);
                    w.z = cvtpk(silu(v1[0] * r) * (bflo(onv.z) - mu) * gr * gv[bj][4], silu(v1[1] * r) * (bfhi(onv.z) - mu) * gr * gv[bj][5]); w.w = cvtpk(silu(v1[2] * r) * (bflo(onv.w) - mu) * gr * gv[bj][6], silu(v1[3] * r) * (bfhi(onv.w) - mu) * gr * gv[bj][7]);
                    *(u32x4*)(rowp + bj * HALF) = w; }
                asm volatile("" ::: "memory"); }
#undef RG_LOAD
    }
};
struct EpiNormRes {
    static constexpr bool AFTER_DRAIN = false; static constexpr bool ROWSTAT = false;
    const bf16_t* xin; bf16_t* xout; float* out32; float* ssq; const float* gpost; unsigned long long* xch; unsigned epoch; LAS unsigned char* tab;
    DI void operator()(Acc& acc, const Unit& u, int wr, int wc, int fr, int fq, const LAS float* rt) const {
        (void)rt;
        const int wid = wr * 4 + wc, lane = fq * 16 + fr;
        LAS float* P = (LAS float*)tab; LAS float* Sg = (LAS float*)(tab + 4096); LAS float* P2 = (LAS float*)(tab + 5120);
        const int col0 = u.pn * BM + wc * 32 + 8 * fq;
        u32x4 xp0[4][2], xp1[4][2];
#pragma unroll
        for (int m = 0; m < 4; ++m)
#pragma unroll
            for (int bj = 0; bj < 2; ++bj) xp0[m][bj] = *(const u32x4*)(xin + (size_t)(u.pm * BM + wr * 64 + m * 16 + fr) * DM + col0 + bj * HALF);
        float gv[2][8];
#pragma unroll
        for (int bj = 0; bj < 2; ++bj) { const f32x4 a = *(const f32x4*)(gpost + col0 + bj * HALF), b = *(const f32x4*)(gpost + col0 + bj * HALF + 4);
            gv[bj][0] = a[0]; gv[bj][1] = a[1]; gv[bj][2] = a[2]; gv[bj][3] = a[3]; gv[bj][4] = b[0]; gv[bj][5] = b[1]; gv[bj][6] = b[2]; gv[bj][7] = b[3]; }
        u32x2 pk[2][4][2];
#pragma unroll
        for (int ai = 1; ai >= 0; --ai) {
#pragma unroll
            for (int m = 0; m < 4; ++m) { float q = 0.f;
#pragma unroll
                for (int bj = 0; bj < 2; ++bj)
#pragma unroll
                    for (int n = 0; n < 2; ++n) { const f32x4 v = acc[ai][bj][m][n]; q += (v[0] * v[0] + v[1] * v[1]) + (v[2] * v[2] + v[3] * v[3]);
                        if (ai == 1) { pk[bj][m][n].x = cvtpk(v[0], v[1]); pk[bj][m][n].y = cvtpk(v[2], v[3]); } }
                q = xsum32(xsum16(q));
                if (fq == 0) P[(ai * HALF + wr * 64 + m * 16 + fr) * 4 + wc] = q; }
            if (ai == 1) { asm volatile("" ::: "memory");
#pragma unroll
                for (int m = 0; m < 4; ++m)
#pragma unroll
                    for (int bj = 0; bj < 2; ++bj) xp1[m][bj] = *(const u32x4*)(xin + (size_t)(u.pm * BM + HALF + wr * 64 + m * 16 + fr) * DM + col0 + bj * HALF);
                asm volatile("" ::: "memory"); }
        }
        LDS_WAIT(); __builtin_amdgcn_s_barrier(); asm volatile("" ::: "memory");
        const int row = wid * 32 + (lane & 31);
        if (lane < 32) { const f32x4 p = *(const LAS f32x4*)(P + row * 4); const float t = (p[0] + p[1]) + (p[2] + p[3]);
            unsigned long long* sl = xch + (size_t)(u.pm * BM + row) * 4;
            __hip_atomic_store(sl + u.pn, ((unsigned long long)epoch << 32) | __float_as_uint(t), __ATOMIC_RELAXED, __HIP_MEMORY_SCOPE_AGENT);
            float tot = 0.f; unsigned sp = 0;
            for (;;) { bool ok = true; tot = 0.f;
#pragma unroll
                for (int k = 0; k < 4; ++k) { const unsigned long long g = __hip_atomic_load(sl + k, __ATOMIC_RELAXED, __HIP_MEMORY_SCOPE_AGENT); ok &= ((unsigned)(g >> 32) == epoch); tot += __uint_as_float((unsigned)g); }
                if (ok || ++sp > (1u << 20)) break;
                __builtin_amdgcn_s_sleep(1); }
            Sg[row] = __builtin_amdgcn_rsqf(tot * (1.0f / DM) + RMS_EPS); }
        LDS_WAIT(); __builtin_amdgcn_s_barrier(); asm volatile("" ::: "memory");
        __builtin_amdgcn_s_waitcnt(0x0F70);
#pragma unroll
        for (int ai = 0; ai < 2; ++ai)
#pragma unroll
            for (int m = 0; m < 4; ++m) { const int r = ai * HALF + wr * 64 + m * 16 + fr; const float rm = Sg[r]; const size_t off = (size_t)(u.pm * BM + r) * DM + col0; float q = 0.f;
#pragma unroll
                for (int bj = 0; bj < 2; ++bj) { const u32x4 xv = ai ? xp1[m][bj] : xp0[m][bj];
                    f32x4 v0, v1;
                    if (ai == 0) { v0 = acc[0][bj][m][0]; v1 = acc[0][bj][m][1]; }
                    else { const u32x2 a = pk[bj][m][0], b = pk[bj][m][1]; v0 = (f32x4){bflo(a.x), bfhi(a.x), bflo(a.y), bfhi(a.y)}; v1 = (f32x4){bflo(b.x), bfhi(b.x), bflo(b.y), bfhi(b.y)}; }
                    float o[8];
                    o[0] = bflo(xv.x) + v0[0] * rm * gv[bj][0]; o[1] = bfhi(xv.x) + v0[1] * rm * gv[bj][1]; o[2] = bflo(xv.y) + v0[2] * rm * gv[bj][2]; o[3] = bfhi(xv.y) + v0[3] * rm * gv[bj][3];
                    o[4] = bflo(xv.z) + v1[0] * rm * gv[bj][4]; o[5] = bfhi(xv.z) + v1[1] * rm * gv[bj][5]; o[6] = bflo(xv.w) + v1[2] * rm * gv[bj][6]; o[7] = bfhi(xv.w) + v1[3] * rm * gv[bj][7];
                    u32x4 w; w.x = cvtpk(o[0], o[1]); w.y = cvtpk(o[2], o[3]); w.z = cvtpk(o[4], o[5]); w.w = cvtpk(o[6], o[7]);
                    *(u32x4*)(xout + off + bj * HALF) = w;
                    if (out32) { *(f32x4*)(out32 + off + bj * HALF) = (f32x4){o[0], o[1], o[2], o[3]}; *(f32x4*)(out32 + off + bj * HALF + 4) = (f32x4){o[4], o[5], o[6], o[7]}; }
                    const float r0 = bflo(w.x), r1 = bfhi(w.x), r2 = bflo(w.y), r3 = bfhi(w.y), r4 = bflo(w.z), r5 = bfhi(w.z), r6 = bflo(w.w), r7 = bfhi(w.w);
                    q += ((r0 * r0 + r1 * r1) + (r2 * r2 + r3 * r3)) + ((r4 * r4 + r5 * r5) + (r6 * r6 + r7 * r7)); }
                q = xsum32(xsum16(q));
                if (fq == 0) P2[r * 4 + wc] = q;
                asm volatile("" ::: "memory"); }
        LDS_WAIT(); __builtin_amdgcn_s_barrier(); asm volatile("" ::: "memory");
        if (lane < 32) { const f32x4 p = *(const LAS f32x4*)(P2 + row * 4); ssq[(size_t)(u.pm * BM + row) * 4 + u.pn] = (p[0] + p[1]) + (p[2] + p[3]); }
    }
};
}

#define XB_TMO      128
#define XB_XCNT(j)  (256  + 64 * (j))
#define XB_XSUB(j)  (1280 + 64 * (j))
#define XB_XGEN(j)  (2304 + 64 * (j))
#define XB_TOP      3328
#define XB_TOPGEN   3392
#define XCD_BAR_WORDS 3456
#define XB_SPIN_CAP (1u << 22)
DI unsigned xb_ld(unsigned* p)              { return __hip_atomic_load(p, __ATOMIC_RELAXED, __HIP_MEMORY_SCOPE_AGENT); }
DI unsigned xb_add(unsigned* p, unsigned v) { return __hip_atomic_fetch_add(p, v, __ATOMIC_RELAXED, __HIP_MEMORY_SCOPE_AGENT); }
DI unsigned xb_xcc_id() { return (unsigned)__builtin_amdgcn_s_getreg((3 << 11) | 20) & 0xFu; }
#define XB_SPIN(cond, bar) do { unsigned _sp = 0; while (cond) { __builtin_amdgcn_s_sleep(1); \
    if ((++_sp & 255u) == 0u) { if (xb_ld(&(bar)[XB_TMO])) break; if (_sp > XB_SPIN_CAP) { atomicAdd(&(bar)[XB_TMO], 1u); break; } } } } while (0)
struct XcdBarrier { unsigned* bar; unsigned x; volatile LAS unsigned* st; };
DI XcdBarrier xcd_barrier_post(unsigned* bar, volatile LAS unsigned* st) {
    XcdBarrier b; b.bar = bar; b.x = xb_xcc_id(); b.st = st;
    if (threadIdx.x == 0) (void)xb_add(&bar[XB_XCNT(b.x)], 1u);
    return b;
}
DI void xcd_barrier_complete(unsigned* bar, unsigned x, unsigned& nloc, unsigned& nx) {
    const unsigned G = gridDim.x * gridDim.y * gridDim.z;
    unsigned sum, cnt, mine, sp = 0u;
    for (;;) {
        sum = 0u; cnt = 0u; mine = 0u;
#pragma unroll
        for (unsigned j = 0; j < 16; ++j) { const unsigned c = xb_ld(&bar[XB_XCNT(j)]); sum += c; cnt += (c > 0u) ? 1u : 0u; mine = (j == x) ? c : mine; }
        if (sum == G) break;
        __builtin_amdgcn_s_sleep(1);
        if ((++sp & 255u) == 0u) { if (xb_ld(&bar[XB_TMO])) break; if (sp > XB_SPIN_CAP) { atomicAdd(&bar[XB_TMO], 1u); break; } }
    }
    nloc = mine > 0u ? mine : 1u; nx = cnt > 0u ? cnt : 1u;
}
DI void xcd_barrier(const XcdBarrier& b) {
    asm volatile("s_waitcnt vmcnt(0)" ::: "memory");
    __syncthreads();
    if (threadIdx.x == 0) {
        unsigned* bar = b.bar; asm volatile("" : "+s"(bar));
        __builtin_amdgcn_s_waitcnt(0);
        unsigned nloc = b.st[0], nx = b.st[1];
        if (nloc == 0u) { xcd_barrier_complete(bar, b.x, nloc, nx); b.st[0] = nloc; b.st[1] = nx; }
        const unsigned old = xb_add(&bar[XB_XSUB(b.x)], 1u);
        const unsigned gen = old / nloc;
        if (old + 1u == (gen + 1u) * nloc) {
            __builtin_amdgcn_fence(__ATOMIC_RELEASE, "agent");
            asm volatile("s_waitcnt vmcnt(0)" ::: "memory");
            const unsigned og = xb_add(&bar[XB_TOP], 1u);
            const unsigned tg = og / nx;
            if (og + 1u == (tg + 1u) * nx) xb_add(&bar[XB_TOPGEN], 1u);
            else XB_SPIN(xb_ld(&bar[XB_TOPGEN]) == tg, bar);
            __builtin_amdgcn_fence(__ATOMIC_ACQUIRE, "agent");
            xb_add(&bar[XB_XGEN(b.x)], 1u);
            asm volatile("s_waitcnt vmcnt(0)" ::: "memory");
        } else {
            XB_SPIN(xb_ld(&bar[XB_XGEN(b.x)]) == gen, bar);
            __builtin_amdgcn_fence(__ATOMIC_ACQUIRE, "agent");
            asm volatile("s_waitcnt vmcnt(0)" ::: "memory");
        }
    }
    __syncthreads();
}

DI void grp_barrier(unsigned* cnt, unsigned& gen, bool same_xcd) {
    asm volatile("s_waitcnt vmcnt(0)" ::: "memory");
    __syncthreads();
    if (threadIdx.x == 0) {
        __builtin_amdgcn_s_waitcnt(0);
        if (!same_xcd) { __builtin_amdgcn_fence(__ATOMIC_RELEASE, "agent"); asm volatile("s_waitcnt vmcnt(0)" ::: "memory"); }
        (void)xb_add(cnt, 1u);
        const unsigned target = 16u * (gen + 1u); unsigned sp = 0;
        while (xb_ld(cnt) < target) { __builtin_amdgcn_s_sleep(1); if (++sp > XB_SPIN_CAP) break; }
        __builtin_amdgcn_fence(__ATOMIC_ACQUIRE, "agent");
        asm volatile("s_waitcnt vmcnt(0)" ::: "memory");
    }
    ++gen;
    __syncthreads();
}

template <int RMAP> DI int rmap(int n) { return RMAP == 0 ? n : (RMAP == 1 ? (n >> 7) * 256 + (n & 127) : (RMAP == 2 ? (n >> 7) * 256 + 128 + (n & 127) : (n & ~31) + 8 * ((n >> 2) & 3) + 4 * ((n >> 4) & 1) + (n & 3))); }
template <int RMAP>
DI void cvt_weight(const float* W, int K, int ldw, int c0, int N, bf16_t* WT, int row_off, const float* gk, const float* gn, float scale, LAS float* scr_, int& rot, int NGW, int lane) {
    LAS bf16_t* scr = (LAS bf16_t*)scr_;
    const int nblk = N / 64, nitems = (K / 64) * nblk;
    const int first = rot; rot = (rot + NGW - nitems % NGW) % NGW;
    const int lr = lane >> 4, lc = (lane & 15) * 4;
    for (int item = first; item < nitems; item += NGW) {
        const int kb = item / nblk, nb = item % nblk, k0 = 64 * kb, n0 = 64 * nb;
        f32x4 gnv = {scale, scale, scale, scale};
        if (gn) { const f32x4 t = *(const f32x4*)(gn + n0 + lc); gnv = t * scale; }
        f32x4 v[16]; float gkq[16];
#pragma unroll
        for (int i = 0; i < 16; ++i) v[i] = *(const f32x4*)(W + (size_t)(k0 + 4 * i + lr) * ldw + c0 + n0 + lc);
#pragma unroll
        for (int i = 0; i < 16; ++i) gkq[i] = gk ? gk[k0 + 4 * i + lr] : 1.f;
        asm volatile("" ::: "memory");
#pragma unroll
        for (int i = 0; i < 16; ++i) { const int kk = 4 * i + lr; const float gkv = gkq[i]; const f32x4 o = v[i] * gnv * gkv;
            scr[(lc + 0) * 72 + kk] = (bf16_t)(cvtpk(o[0], 0.f) & 0xffffu); scr[(lc + 1) * 72 + kk] = (bf16_t)(cvtpk(o[1], 0.f) & 0xffffu);
            scr[(lc + 2) * 72 + kk] = (bf16_t)(cvtpk(o[2], 0.f) & 0xffffu); scr[(lc + 3) * 72 + kk] = (bf16_t)(cvtpk(o[3], 0.f) & 0xffffu); }
        LDS_WAIT(); asm volatile("" ::: "memory");
#pragma unroll
        for (int j = 0; j < 8; ++j) { const int n = 8 * j + (lane >> 3), c = lane & 7; const u32x4 o = *(const LAS u32x4*)(scr + n * 72 + 8 * c);
            *(u32x4*)(WT + (size_t)(row_off + rmap<RMAP>(n0 + n)) * K + k0 + 8 * c) = o; }
        LDS_WAIT(); asm volatile("" ::: "memory");
    }
}
DI void cvt_rows(const float* W, int K, bf16_t* dst, const float* gk, float scale, int& rot, int NGW, int lane) {
    const int first = rot; rot = (rot + NGW - K % NGW) % NGW;
    for (int k = first; k < K; k += NGW) { const float g = gk[k] * scale; const f32x4* xr = (const f32x4*)(W + (size_t)k * DM) + lane; u32x2* o8 = (u32x2*)(dst + (size_t)k * DM) + lane;
#pragma unroll
        for (int j = 0; j < 4; ++j) { const f32x4 v = xr[64 * j] * g; u32x2 w; w.x = cvtpk(v[0], v[1]); w.y = cvtpk(v[2], v[3]); o8[64 * j] = w; } }
}
DI void rows_to_bf16(const float* X, bf16_t* XB, float* RSTD, int nrows, float* Xcopy, int gw, int NGW, int lane) {
    asm volatile("" : "+v"(lane));
    (void)Xcopy;
    for (int row0 = 2 * gw; row0 < nrows; row0 += 2 * NGW) {
        f32x4 v[2][4]; float s[2];
#pragma unroll
        for (int k = 0; k < 2; ++k) { const f32x4* xr = (const f32x4*)(X + (size_t)(row0 + k) * DM) + lane;
#pragma unroll
            for (int j = 0; j < 4; ++j) v[k][j] = xr[64 * j]; }
#pragma unroll
        for (int k = 0; k < 2; ++k) { float q = 0.f;
#pragma unroll
            for (int j = 0; j < 4; ++j) q += (v[k][j][0] * v[k][j][0] + v[k][j][1] * v[k][j][1]) + (v[k][j][2] * v[k][j][2] + v[k][j][3] * v[k][j][3]);
            s[k] = wave_sum(q); }
#pragma unroll
        for (int k = 0; k < 2; ++k) {
            if (lane == 0) *(f32x4*)(RSTD + (size_t)(row0 + k) * 4) = (f32x4){s[k], 0.f, 0.f, 0.f};
            u32x2* o8 = (u32x2*)(XB + (size_t)(row0 + k) * DM) + lane;
#pragma unroll
            for (int j = 0; j < 4; ++j) { u32x2 w; w.x = cvtpk(v[k][j][0], v[k][j][1]); w.y = cvtpk(v[k][j][2], v[k][j][3]); o8[64 * j] = w; } }
    }
}
DI void pool_pre(const bf16_t* X, const float* SSQ, const float* gpre, bf16_t* DP, int run0, int run_end, int run_step, int tid) {
    asm volatile("" : "+v"(tid));
    const int lane = tid & 63;
    const int c = 4 * (tid & 255), w = __builtin_amdgcn_readfirstlane(2 << (c >> 8));
    const f32x4 g = *(const f32x4*)(gpre + c);
    const float invw = __builtin_amdgcn_rcpf((float)w);
    for (int run = run0 + (tid >> 8) * run_step; run < run_end; run += 2 * run_step) {
        const int r0 = run * 64, tp0 = r0 & (SEQ - 1);
        const int ra = r0 - 16 + lane;
        const int rsA = __float_as_int(rstd_of(SSQ, ra < 0 ? 0 : ra)), rsB = __float_as_int(rstd_of(SSQ, r0 + 48 + (lane & 15)));
#define PP_RS(row_) (((row_) - (r0 - 16)) < 64 ? __int_as_float(__builtin_amdgcn_readlane(rsA, (row_) - (r0 - 16))) : __int_as_float(__builtin_amdgcn_readlane(rsB, (row_) - (r0 + 48))))
        f32x4 s = {0.f, 0.f, 0.f, 0.f};
        for (int j = 1; j < w; ++j) { if (tp0 - j >= 0) { const u32x2 xv = *(const u32x2*)(X + (size_t)(r0 - j) * DM + c); const float rs = PP_RS(r0 - j);
            s += (f32x4){bflo(xv.x), bfhi(xv.x), bflo(xv.y), bfhi(xv.y)} * rs * g; } }
#pragma unroll 1
        for (int i0 = 0; i0 < 64; i0 += 8) {
            u32x2 xv[8], xl[8];
#pragma unroll
            for (int k = 0; k < 8; ++k) { const int row = r0 + i0 + k, tp = tp0 + i0 + k; const int lrow = (tp - w + 1 >= 0) ? row - w + 1 : row;
                xv[k] = *(const u32x2*)(X + (size_t)row * DM + c); xl[k] = *(const u32x2*)(X + (size_t)lrow * DM + c); }
#pragma unroll
            for (int k = 0; k < 8; ++k) { const int row = r0 + i0 + k, tp = tp0 + i0 + k; const int lrow = (tp - w + 1 >= 0) ? row - w + 1 : row;
                const float rsk = PP_RS(row), rlk = PP_RS(lrow);
                const f32x4 h = (f32x4){bflo(xv[k].x), bfhi(xv[k].x), bflo(xv[k].y), bfhi(xv[k].y)} * rsk * g;
                s += h;
                const float inv = (tp + 1 < w) ? __builtin_amdgcn_rcpf((float)(tp + 1)) : invw;
                const f32x4 d = s * inv - h;
                u32x2 o; o.x = cvtpk(d[0], d[1]); o.y = cvtpk(d[2], d[3]);
                *(u32x2*)(DP + (size_t)row * DM + c) = o;
                if (tp - w + 1 >= 0) s -= (f32x4){bflo(xl[k].x), bfhi(xl[k].x), bflo(xl[k].y), bfhi(xl[k].y)} * rlk * g; }
        }
#undef PP_RS
    }
}

#define MFMA32(a, b, c) __builtin_amdgcn_mfma_f32_32x32x16_bf16((a), (b), (c), 0, 0, 0)
#define MFMA16(a, b, c) __builtin_amdgcn_mfma_f32_16x16x32_bf16((a), (b), (c), 0, 0, 0)
#define SB_SUBTILE(Z, DIAG, ALLV, A, RUN) do { float sg_[16], kp_[16]; \
        _Pragma("unroll") for (int i = 0; i < 16; ++i) { const int ko = (i & 3) + 8 * (i >> 2) + 4 * hh; const bool valid = (ALLV) && (!(DIAG) || (ko < r)); \
              \
            const float zz = __builtin_amdgcn_fmed3f(Z[i], -126.0f, 126.0f), e = ex2(-zz), rc = __builtin_amdgcn_rcpf(1.0f + e), er = e * rc; \
            sg_[i] = valid ? rc : 0.f; kp_[i] = valid ? er : 1.f; } \
        float pg_[4], tg_[4];        \
        _Pragma("unroll") for (int g = 0; g < 4; ++g) { const float gp_ = (kp_[4 * g] * kp_[4 * g + 1]) * (kp_[4 * g + 2] * kp_[4 * g + 3]); \
            const auto sw_ = __builtin_amdgcn_permlane32_swap(__float_as_uint(gp_), __float_as_uint(gp_), false, false); const float r0_ = __uint_as_float(sw_[0]), r1_ = __uint_as_float(sw_[1]); \
            pg_[g] = r0_ * r1_; tg_[g] = hh ? 1.f : r1_; } \
        float run_ = 1.f, aft_[4]; \
        _Pragma("unroll") for (int g = 3; g >= 0; --g) { aft_[g] = run_ * tg_[g]; run_ *= pg_[g]; } \
        _Pragma("unroll") for (int g = 0; g < 4; ++g) { float c = aft_[g] * F; \
            _Pragma("unroll") for (int k = 3; k >= 0; --k) { A[4 * g + k] = sg_[4 * g + k] * c; c *= kp_[4 * g + k]; } } \
        RUN = run_; } while (0)
DI void sb_attention(const bf16_t* QK, const bf16_t* VT, bf16_t* O, LAS unsigned char* lds, int vcu, int G, int tid_in) {
    int tid = tid_in; asm volatile("" : "+v"(tid));
    const int lane = tid & 63, wave = __builtin_amdgcn_readfirstlane(tid >> 6), r = lane & 31, hh = lane >> 5;
    for (int bh = vcu; bh < NB * 16; bh += G) {
        const int h = bh & 15, b = bh >> 4;
        const bf16_t* kbase = QK + (size_t)(b * SEQ + r) * 2048 + 1024 + h * 64 + 8 * hh;
        const bf16_t* vbase = VT + ((size_t)b * 1024 + h * 64 + r) * LDT + 4 * hh;
        unsigned koff[4], voff[4];
#pragma unroll
        for (int q = 0; q < 4; ++q) { const int sl = (wave * 4 + q) * 64 + lane;
            { const int row = sl >> 3, piece = (sl & 7) ^ (row & 7); koff[q] = (unsigned)(row * 2048 + piece * 8); }
            { const int d = sl >> 5, sp = sl & 31; voff[q] = (unsigned)(d * LDT + (sp ^ (d & 15)) * 8); } }
#pragma unroll 1
        for (int unit = 0; unit < SEQ / 256; ++unit) {
            const int T0 = unit * 256, half = unit & 1, t0 = T0 + wave * 32;
            const bf16_t* qp = QK + (size_t)(b * SEQ + t0 + r) * 2048 + h * 64 + 8 * hh;
            bf16x8 qf[4];
#pragma unroll
            for (int s = 0; s < 4; ++s) qf[s] = *(const bf16x8*)(qp + 16 * s);
            asm volatile("s_waitcnt lgkmcnt(0)" ::: "memory"); __builtin_amdgcn_s_barrier(); asm volatile("" ::: "memory");
            {   const bf16_t* ksrc = QK + (size_t)(b * SEQ + T0) * 2048 + 1024 + h * 64; const bf16_t* vsrc = VT + ((size_t)b * 1024 + h * 64) * LDT + T0;
#pragma unroll
                for (int q = 0; q < 4; ++q) {
                    __builtin_amdgcn_global_load_lds((const unsigned*)(ksrc + koff[q]), (LAS unsigned*)(lds + half * 32768 + (wave * 4 + q) * 1024), 16, 0, 0);
                    __builtin_amdgcn_global_load_lds((const unsigned*)(vsrc + voff[q]), (LAS unsigned*)(lds + 65536 + half * 32768 + (wave * 4 + q) * 1024), 16, 0, 0); } }
            asm volatile("s_waitcnt vmcnt(0)" ::: "memory"); __builtin_amdgcn_s_barrier(); asm volatile("" ::: "memory");
            const int ring_lo = T0 >= 256 ? T0 - 256 : 0;
            f32x16 o0, o1;
#pragma unroll
            for (int i = 0; i < 16; ++i) { o0[i] = 0.f; o1[i] = 0.f; }
            float F = 1.f, R = 0.f;
            int sb = t0 - 32;
            for (;;) {
                const bool lval = sb >= 0; const int sbl = lval ? sb : 0, sbh = sb + 32;
                bf16x8 kH[4], kL[4]; bf16x4 vH[2][2][2], vL[2][2][2];
                const bool ring = sbl >= ring_lo;
                if (ring) {
                    const int rh = (sbh + r) & 511, rl = (sbl + r) & 511;
#pragma unroll
                    for (int s = 0; s < 4; ++s) { kH[s] = *(const LAS bf16x8*)(lds + rh * 128 + (((2 * s + hh) ^ (rh & 7)) << 4)); kL[s] = *(const LAS bf16x8*)(lds + rl * 128 + (((2 * s + hh) ^ (rl & 7)) << 4)); }
                } else {
#pragma unroll
                    for (int s = 0; s < 4; ++s) { kH[s] = *(const bf16x8*)(kbase + (size_t)sbh * 2048 + 16 * s); kL[s] = *(const bf16x8*)(kbase + (size_t)sbl * 2048 + 16 * s); }
#pragma unroll
                    for (int dt = 0; dt < 2; ++dt)
#pragma unroll
                        for (int s = 0; s < 2; ++s)
#pragma unroll
                            for (int p = 0; p < 2; ++p) { vH[dt][s][p] = *(const bf16x4*)(vbase + (size_t)dt * 32 * LDT + sbh + 16 * s + 8 * p); vL[dt][s][p] = *(const bf16x4*)(vbase + (size_t)dt * 32 * LDT + sbl + 16 * s + 8 * p); }
                }
                const int nsb = sb - 64; const bool more = nsb >= -32;
                f32x16 zH, zL;
#pragma unroll
                for (int i = 0; i < 16; ++i) { zH[i] = 0.f; zL[i] = 0.f; }
#pragma unroll
                for (int s = 0; s < 4; ++s) { zH = MFMA32(kH[s], qf[s], zH); zL = MFMA32(kL[s], qf[s], zL); }
                if (ring) {
#pragma unroll
                    for (int dt = 0; dt < 2; ++dt)
#pragma unroll
                        for (int s = 0; s < 2; ++s)
#pragma unroll
                            for (int p = 0; p < 2; ++p) { const int d = 32 * dt + r; const int ph = ((sbh & 255) >> 3) + 2 * s + p, pl = ((sbl & 255) >> 3) + 2 * s + p;
                                vH[dt][s][p] = *(const LAS bf16x4*)(lds + 65536 + ((sbh >> 8) & 1) * 32768 + d * 512 + ((ph ^ (d & 15)) << 4) + hh * 8);
                                vL[dt][s][p] = *(const LAS bf16x4*)(lds + 65536 + ((sbl >> 8) & 1) * 32768 + d * 512 + ((pl ^ (d & 15)) << 4) + hh * 8); }
                }
                float aH[16], aL[16], runH, runL;
                if (sbh == t0) SB_SUBTILE(zH, true, true, aH, runH); else SB_SUBTILE(zH, false, true, aH, runH);
                F *= runH;
                if (lval) SB_SUBTILE(zL, false, true, aL, runL);
                else {
#pragma unroll
                    for (int i = 0; i < 16; ++i) aL[i] = 0.f;
                    runL = 1.f; }
                F *= runL;
                R -= lg2(runH) + lg2(runL);
#pragma unroll
                for (int s = 0; s < 2; ++s) {
                    u32x4 w; w.x = cvtpk(aH[8 * s + 0], aH[8 * s + 1]); w.y = cvtpk(aH[8 * s + 2], aH[8 * s + 3]); w.z = cvtpk(aH[8 * s + 4], aH[8 * s + 5]); w.w = cvtpk(aH[8 * s + 6], aH[8 * s + 7]);
                    const bf16x8 pH = __builtin_bit_cast(bf16x8, w);
                    w.x = cvtpk(aL[8 * s + 0], aL[8 * s + 1]); w.y = cvtpk(aL[8 * s + 2], aL[8 * s + 3]); w.z = cvtpk(aL[8 * s + 4], aL[8 * s + 5]); w.w = cvtpk(aL[8 * s + 6], aL[8 * s + 7]);
                    const bf16x8 pL = __builtin_bit_cast(bf16x8, w);
                    o0 = MFMA32(__builtin_shufflevector(vH[0][s][0], vH[0][s][1], 0, 1, 2, 3, 4, 5, 6, 7), pH, o0); o1 = MFMA32(__builtin_shufflevector(vH[1][s][0], vH[1][s][1], 0, 1, 2, 3, 4, 5, 6, 7), pH, o1);
                    o0 = MFMA32(__builtin_shufflevector(vL[0][s][0], vL[0][s][1], 0, 1, 2, 3, 4, 5, 6, 7), pL, o0); o1 = MFMA32(__builtin_shufflevector(vL[1][s][0], vL[1][s][1], 0, 1, 2, 3, 4, 5, 6, 7), pL, o1); }
                if (!more) break;
                if (__all(R >= 151.0f)) break;
                sb = nsb;
            }
            bf16_t* op = O + (size_t)(b * SEQ + t0 + r) * DM + h * 64 + 4 * hh;
#pragma unroll
            for (int g = 0; g < 4; ++g) {
                u32x2 w; w.x = cvtpk(o0[4 * g], o0[4 * g + 1]); w.y = cvtpk(o0[4 * g + 2], o0[4 * g + 3]); *(u32x2*)(op + 8 * g) = w;
                w.x = cvtpk(o1[4 * g], o1[4 * g + 1]); w.y = cvtpk(o1[4 * g + 2], o1[4 * g + 3]); *(u32x2*)(op + 32 + 8 * g) = w; }
        }
        asm volatile("s_waitcnt lgkmcnt(0)" ::: "memory"); __builtin_amdgcn_s_barrier(); asm volatile("" ::: "memory");
    }
}

DI void ret_scores(const bf16_t* QKn, bf16_t* SC, int u0, int u_end, int u_step, int lane) {
    asm volatile("" : "+v"(lane));
    const int fr = lane & 15, fq = lane >> 4;
    for (int u = u0; u < u_end; u += u_step) {
        const int c = u & 63, h = (u >> 6) & 3, bl = u >> 8;
        const bf16_t* qb = QKn + (size_t)(bl * SEQ + c * 64) * 2048 + h * 256 + 8 * fq;
        const bf16_t* kbp = qb + 1024;
        bf16_t* sc = SC + (size_t)u * 4096;
#pragma unroll 1
        for (int nt = 0; nt < 4; ++nt) {
            bf16x8 qf[8];
#pragma unroll
            for (int ks = 0; ks < 8; ++ks) qf[ks] = *(const bf16x8*)(qb + (size_t)(16 * nt + fr) * 2048 + 32 * ks);
#pragma unroll 1
            for (int mt = 0; mt < 4; ++mt) {
                f32x4 acc = {0.f, 0.f, 0.f, 0.f};
                if (mt <= nt) {
#pragma unroll
                    for (int ks = 0; ks < 8; ++ks) { const bf16x8 kr = *(const bf16x8*)(kbp + (size_t)(16 * mt + fr) * 2048 + 32 * ks); const bf16x8 kf = (fr & 8) ? __builtin_shufflevector(kr, kr, 4, 5, 6, 7, 0, 1, 2, 3) : kr;     acc = MFMA16(kf, qf[ks], acc); }
                    const int n = 16 * nt + fr;
#pragma unroll
                    for (int i = 0; i < 4; ++i) { const int m = 16 * mt + 4 * fq + i; acc[i] = (n >= m) ? acc[i] : 0.f; }
                }
                u32x2 w; w.x = cvtpk(acc[0], acc[1]); w.y = cvtpk(acc[2], acc[3]);
                *(u32x2*)(sc + (16 * nt + fr) * 64 + 16 * mt + 4 * fq) = w;
            }
        }
    }
}
DI void ret_scan(const bf16_t* QKn, const bf16_t* KVT, const bf16_t* SC, bf16_t* O, float* gns, LAS unsigned char* lds, int vcu, int G, int tid_in) {
    int tid = tid_in; asm volatile("" : "+v"(tid));
    const int lane = tid & 63, wave = __builtin_amdgcn_readfirstlane(tid >> 6), fr = lane & 15, fq = lane >> 4;
    LAS unsigned char* OUT = lds + SMX_OFF;
    constexpr int OUTP = 272;
    for (int task = vcu; task < NB * 16; task += G) {
        const int eb = task & 3, h = (task >> 2) & 3, bl = task >> 4, e0 = eb * 128 + wave * 16;
        const float g64 = ex2(64.0f * lg2(1.0f - ex2(-5.0f - (float)h)));
        const bf16_t* qsrc = QKn + (size_t)(bl * SEQ) * 2048 + h * 256;
        const bf16_t* vtp = KVT + (size_t)bl * 2048 * LDR + (size_t)(h * 512 + e0 + fr) * LDR + 8 * fq;
        const bf16_t* scp = SC + (size_t)((bl * 4 + h) * 64) * 4096 + fr * 64 + 8 * fq;
        bf16_t* ob = O + (size_t)(bl * SEQ) * 2048 + h * 512 + eb * 128;
#define RS_DMA(c_, buf_) do { int ln_ = lane; asm volatile("" : "+v"(ln_)); _Pragma("unroll") for (int q = 0; q < 4; ++q) { const int sl = (wave * 4 + q) * 64 + ln_, row = sl >> 5; \
            const unsigned qo = (unsigned)(row * 2048 + (((sl & 31) ^ (row & 15)) << 3)), ko = (unsigned)(row * 2048 + (((sl & 31) ^ ((row & 3) << 2)) << 3)) + 1024u;     \
            __builtin_amdgcn_global_load_lds((const unsigned*)(qsrc + (size_t)(c_) * 64 * 2048 + qo), (LAS unsigned*)(lds + (buf_) * 65536 + (wave * 4 + q) * 1024), 16, 0, 0); \
            __builtin_amdgcn_global_load_lds((const unsigned*)(qsrc + (size_t)(c_) * 64 * 2048 + ko), (LAS unsigned*)(lds + (buf_) * 65536 + 32768 + (wave * 4 + q) * 1024), 16, 0, 0); } } while (0)
#define RS_STORE_OUT(c_) do { _Pragma("unroll") for (int q = 0; q < 2; ++q) { const int idx = tid + 512 * q, p = idx >> 4, pc = idx & 15; \
            const u32x4 v = *(const LAS u32x4*)(OUT + p * OUTP + pc * 16); *(u32x4*)(ob + (size_t)(p * 64 + (c_)) * 2048 + pc * 8) = v; \
            const float a0 = bflo(v.x), a1 = bfhi(v.x), a2 = bflo(v.y), a3 = bfhi(v.y), a4 = bflo(v.z), a5 = bfhi(v.z), a6 = bflo(v.w), a7 = bfhi(v.w); \
            float s1 = ((a0 + a1) + (a2 + a3)) + ((a4 + a5) + (a6 + a7)), s2 = ((a0 * a0 + a1 * a1) + (a2 * a2 + a3 * a3)) + ((a4 * a4 + a5 * a5) + (a6 * a6 + a7 * a7)); \
            s1 = rowsum16(s1); s2 = rowsum16(s2); \
            if (pc == 0) *(f32x2*)(gns + (size_t)(bl * SEQ + p * 64 + (c_)) * 32 + h * 8 + eb * 2) = (f32x2){s1, s2}; } } while (0)
        f32x4 S[16];
#pragma unroll
        for (int T = 0; T < 16; ++T) S[T] = (f32x4){0.f, 0.f, 0.f, 0.f};
        bf16x8 scr[8], vcur[2], vnext[2];
        RS_DMA(0, 0);
#pragma unroll
        for (int k2 = 0; k2 < 2; ++k2) { vcur[k2] = *(const bf16x8*)(vtp + 32 * k2); vnext[k2] = vcur[k2]; }
#pragma unroll
        for (int k2 = 0; k2 < 2; ++k2)
#pragma unroll
            for (int nt = 0; nt < 4; ++nt) scr[k2 * 4 + nt] = *(const bf16x8*)(scp + (16 * nt) * 64 + 32 * k2);
#pragma unroll 1
        for (int c = 0; c < 64; ++c) {
            asm volatile("s_waitcnt vmcnt(0) lgkmcnt(0)" ::: "memory"); __builtin_amdgcn_s_barrier(); asm volatile("" ::: "memory");
            const int buf = c & 1;
            if (c + 1 < 64) { RS_DMA(c + 1, buf ^ 1);
#pragma unroll
                for (int k2 = 0; k2 < 2; ++k2) vnext[k2] = *(const bf16x8*)(vtp + (c + 1) * 64 + 32 * k2); }
            if (c > 0) RS_STORE_OUT(c - 1);
            const LAS unsigned char* Qb = lds + buf * 65536; LAS unsigned char* Kb = lds + buf * 65536 + 32768;
            int q4 = fr >> 2; asm volatile("" : "+v"(q4));
            LAS unsigned char* krow = Kb + (8 * fq + q4) * 512 + (fr & 3) * 16;
            f32x4 acc[4];
#pragma unroll
            for (int nt = 0; nt < 4; ++nt) acc[nt] = (f32x4){0.f, 0.f, 0.f, 0.f};
            bf16x8 aQ[3][4];
#define RS_QREAD(bufi, KS) do { const unsigned qa_ = (unsigned)(size_t)(Qb + fr * 512 + (((4 * (KS) + fq) ^ fr) << 4)); \
                asm volatile("ds_read_b128 %0, %1" : "=v"(aQ[bufi][0]) : "v"(qa_)); asm volatile("ds_read_b128 %0, %1 offset:8192" : "=v"(aQ[bufi][1]) : "v"(qa_)); \
                asm volatile("ds_read_b128 %0, %1 offset:16384" : "=v"(aQ[bufi][2]) : "v"(qa_)); asm volatile("ds_read_b128 %0, %1 offset:24576" : "=v"(aQ[bufi][3]) : "v"(qa_)); } while (0)
#define RS_QWAIT(bufi, N) asm volatile("s_waitcnt lgkmcnt(" #N ")" : "+v"(aQ[bufi][0]), "+v"(aQ[bufi][1]), "+v"(aQ[bufi][2]), "+v"(aQ[bufi][3]))
            RS_QREAD(0, 0); RS_QREAD(1, 1);
#pragma unroll
            for (int ks = 0; ks < 8; ++ks) {
                if (ks < 6) { RS_QREAD((ks + 2) % 3, ks + 2); RS_QWAIT(ks % 3, 8); }
                else if (ks == 6) RS_QWAIT(ks % 3, 4);
                else RS_QWAIT(ks % 3, 0);
                u32x4 w; w.x = cvtpk(S[2 * ks][0], S[2 * ks][1]); w.y = cvtpk(S[2 * ks][2], S[2 * ks][3]); w.z = cvtpk(S[2 * ks + 1][0], S[2 * ks + 1][1]); w.w = cvtpk(S[2 * ks + 1][2], S[2 * ks + 1][3]);
                const bf16x8 bS = __builtin_bit_cast(bf16x8, w);
#pragma unroll
                for (int nt = 0; nt < 4; ++nt) acc[nt] = MFMA16(bS, aQ[ks % 3][nt], acc[nt]);
            }
#undef RS_QREAD
#undef RS_QWAIT
#pragma unroll
            for (int nt = 0; nt < 4; ++nt) acc[nt] *= g64;
#pragma unroll
            for (int k2 = 0; k2 < 2; ++k2)
#pragma unroll
                for (int nt = 0; nt < 4; ++nt) acc[nt] = MFMA16(vcur[k2], scr[k2 * 4 + nt], acc[nt]);
            if (c + 1 < 64) {
#pragma unroll
                for (int k2 = 0; k2 < 2; ++k2)
#pragma unroll
                    for (int nt = 0; nt < 4; ++nt) scr[k2 * 4 + nt] = *(const bf16x8*)(scp + (size_t)(c + 1) * 4096 + (16 * nt) * 64 + 32 * k2); }
            asm volatile("s_waitcnt lgkmcnt(0)" ::: "memory"); __builtin_amdgcn_s_barrier(); asm volatile("" ::: "memory");
#pragma unroll
            for (int nt = 0; nt < 4; ++nt) { u32x2 w; w.x = cvtpk(acc[nt][0], acc[nt][1]); w.y = cvtpk(acc[nt][2], acc[nt][3]);
                *(LAS u32x2*)(OUT + (16 * nt + fr) * OUTP + wave * 32 + fq * 8) = w; }
            const int hsw8 = (fq & 1) * 8;
            bf16x4 kf[4][4];
#define RS_KREAD(bufi, TT) do { const unsigned ka_ = (unsigned)(size_t)(krow + (((((TT) >> 1) ^ q4) << 6) + ((((TT) & 1) * 8) ^ hsw8))); \
                asm volatile("ds_read_b64_tr_b16 %0, %1" : "=v"(kf[bufi][0]) : "v"(ka_)); asm volatile("ds_read_b64_tr_b16 %0, %1 offset:2048" : "=v"(kf[bufi][1]) : "v"(ka_)); \
                asm volatile("ds_read_b64_tr_b16 %0, %1 offset:16384" : "=v"(kf[bufi][2]) : "v"(ka_)); asm volatile("ds_read_b64_tr_b16 %0, %1 offset:18432" : "=v"(kf[bufi][3]) : "v"(ka_)); } while (0)
#define RS_KWAIT(bufi, N) asm volatile("s_waitcnt lgkmcnt(" #N ")" : "+v"(kf[bufi][0]), "+v"(kf[bufi][1]), "+v"(kf[bufi][2]), "+v"(kf[bufi][3]))
            RS_KREAD(0, 0); RS_KREAD(1, 1); RS_KREAD(2, 2);
#pragma unroll
            for (int T = 0; T < 16; ++T) {
                if (T < 13) { RS_KREAD((T + 3) & 3, T + 3); RS_KWAIT(T & 3, 12); }
                else if (T == 13) RS_KWAIT(T & 3, 8);
                else if (T == 14) RS_KWAIT(T & 3, 4);
                else RS_KWAIT(T & 3, 0);
                f32x4 sv = S[T] * g64;
#pragma unroll
                for (int k2 = 0; k2 < 2; ++k2) { const bf16x8 aK = __builtin_shufflevector(kf[T & 3][2 * k2], kf[T & 3][2 * k2 + 1], 0, 1, 2, 3, 4, 5, 6, 7); sv = MFMA16(aK, vcur[k2], sv); }
                S[T] = sv;
            }
#undef RS_KWAIT
#undef RS_KREAD
            vcur[0] = vnext[0]; vcur[1] = vnext[1];
        }
        asm volatile("s_waitcnt vmcnt(0) lgkmcnt(0)" ::: "memory"); __builtin_amdgcn_s_barrier(); asm volatile("" ::: "memory");
        RS_STORE_OUT(63);
        asm volatile("s_waitcnt lgkmcnt(0)" ::: "memory"); __builtin_amdgcn_s_barrier(); asm volatile("" ::: "memory");
#undef RS_DMA
#undef RS_STORE_OUT
    }
}
DI GAS unsigned char* opq(unsigned char* p) { GAS unsigned char* q = (GAS unsigned char*)p; asm volatile("" : "+s"(q)); return q; }
struct Args { const float* in[21]; float* out; unsigned char* ws; };
static_assert(sizeof(Args) == 23 * 8, "no padding");

__global__ void __launch_bounds__(512, 2) fwd_kernel(Args args) {
    extern __shared__ __attribute__((aligned(16))) unsigned char lds_raw[];
    LAS unsigned char* lds = (LAS unsigned char*)lds_raw;
    volatile LAS unsigned* MISC = (volatile LAS unsigned*)(lds + MISC_OFF);
    const int tid = threadIdx.x, lane = tid & 63, wave = __builtin_amdgcn_readfirstlane(tid >> 6);
    const int G = gridDim.x, bx = blockIdx.x, vcu = (G % 8 == 0) ? (bx % 8) * (G / 8) + bx / 8 : bx;
    const int gw = vcu * 8 + wave, NGW = G * 8;
    const int grp = vcu >> 4, wg16 = vcu & 15;
    unsigned char* ws = args.ws;
    unsigned* ctl = (unsigned*)(ws + WS_CTL);
    for (int u = tid; u < 64; u += 512) ((LAS unsigned*)(lds + MISC_OFF))[u] = 0u;
    __syncthreads();
    XcdBarrier bar = xcd_barrier_post(ctl + CW_BAR, MISC + 8);
#define GRID_BAR() xcd_barrier(bar)
    if (tid == 0) (void)__hip_atomic_fetch_or(ctl + CW_GRP + 64 * (16 + (vcu >> 4)), 1u << xb_xcc_id(), __ATOMIC_RELAXED, __HIP_MEMORY_SCOPE_AGENT);

    const float* x_in = args.in[0]; const float* mem = args.in[1];
    const float* n_mix_pre = args.in[2]; const float* n_mix_post = args.in[3]; const float* n_xa_pre = args.in[4]; const float* n_xa_post = args.in[5];
    const float* n_mem = args.in[6]; const float* n_ffn_pre = args.in[7]; const float* n_ffn_post = args.in[8];
    const float* pool_w = args.in[9]; const float* pool_scale = args.in[10]; const float* sb_w_in = args.in[11]; const float* sb_w_out = args.in[12];
    const float* ret_w_in = args.in[13]; const float* ret_gn = args.in[14]; const float* ret_w_out = args.in[15];
    const float* xa_w_q = args.in[16]; const float* xa_w_kv = args.in[17]; const float* xa_w_o = args.in[18]; const float* ffn_w_in = args.in[19]; const float* ffn_w_out = args.in[20];
    float* X = args.out;
#define RSTD  ((float*)(GAS float*)(opq(ws) + WS_SSQ))
#define MRSTD ((float*)(GAS float*)(opq(ws) + WS_MRSTD))
#define cosN  ((float*)(GAS float*)(opq(ws) + WS_ROPE))
#define sinN  ((float*)(GAS float*)(opq(ws) + WS_ROPE + 2 * MiB))
#define cosT  ((float*)(GAS float*)(opq(ws) + WS_ROPE + 4 * MiB))
#define sinT  ((float*)(GAS float*)(opq(ws) + WS_ROPE + 6 * MiB))
#define MEMB  ((bf16_t*)(GAS bf16_t*)(opq(ws) + WS_MEMB))
#define KMEM  ((bf16_t*)(GAS bf16_t*)(opq(ws) + WS_KMEM))
#define VTMEM ((bf16_t*)(GAS bf16_t*)(opq(ws) + WS_VTMEM))
#define WB    ((bf16_t*)(GAS bf16_t*)(opq(ws) + WS_WB))
#define XB    ((bf16_t*)(GAS bf16_t*)(opq(ws) + WS_XB))
#define R     ((unsigned char*)(opq(ws) + WS_R))

    {
        LAS float* scr = (LAS float*)(lds + wave * 16384); int rot = gw;
        for (int j = 0; j < 2; ++j) {
            for (int g = 0; g < 4; ++g)
                cvt_weight<0>(pool_w + (size_t)(j * 4 + g) * 65536, 256, 256, 0, 256, WB + WO_POOL + (size_t)(j * 4 + g) * 65536, 0, nullptr, pool_scale + j * DM + g * 256, 1.f, scr, rot, NGW, lane);
        }
        cvt_weight<0>(sb_w_in, 1024, 3072, 0, 1024, WB + WO_SB_QK, 0, n_mix_pre + 1 * DM, nullptr, 0.125f * LOG2E, scr, rot, NGW, lane);
        cvt_weight<0>(sb_w_in, 1024, 3072, 1024, 1024, WB + WO_SB_QK, 1024, n_mix_pre + 1 * DM, nullptr, 1.f, scr, rot, NGW, lane);
        cvt_weight<0>(sb_w_in, 1024, 3072, 2048, 1024, WB + WO_SB_V, 0, n_mix_pre + 1 * DM, nullptr, 1.f, scr, rot, NGW, lane);
        cvt_weight<0>(sb_w_out, 1024, 1024, 0, 1024, WB + WO_SB_O, 0, nullptr, nullptr, 1.f, scr, rot, NGW, lane);
        cvt_weight<3>(ret_w_in, 1024, 6144, 0, 1024, WB + WO_RT_QK, 0, n_mix_pre + 2 * DM, nullptr, 1.f, scr, rot, NGW, lane);
        cvt_weight<3>(ret_w_in, 1024, 6144, 1024, 1024, WB + WO_RT_QK, 1024, n_mix_pre + 2 * DM, nullptr, 0.0625f, scr, rot, NGW, lane);
        cvt_weight<0>(ret_w_in, 1024, 6144, 2048, 2048, WB + WO_RT_KV, 0, n_mix_pre + 2 * DM, nullptr, 1.f, scr, rot, NGW, lane);
        cvt_weight<0>(ret_w_in, 1024, 6144, 4096, 2048, WB + WO_RT_G, 0, n_mix_pre + 2 * DM, nullptr, 1.f, scr, rot, NGW, lane);
        cvt_weight<0>(ret_w_out, 2048, 1024, 0, 1024, WB + WO_RT_O, 0, nullptr, nullptr, 1.f, scr, rot, NGW, lane);
        for (int i = 0; i < DEPTH; ++i) {
            cvt_rows(xa_w_q + (size_t)i * 1048576, 1024, WB + WO_XA_Q + (size_t)i * 1048576, n_xa_pre + i * DM, 0.0625f * LOG2E, rot, NGW, lane);
            cvt_weight<0>(xa_w_kv + (size_t)i * 2097152, 1024, 2048, 0, 1024, WB + WO_XA_K + (size_t)i * 1048576, 0, n_mem + i * DM, nullptr, 1.f, scr, rot, NGW, lane);
            cvt_weight<0>(xa_w_kv + (size_t)i * 2097152, 1024, 2048, 1024, 1024, WB + WO_XA_V + (size_t)i * 1048576, 0, n_mem + i * DM, nullptr, 1.f, scr, rot, NGW, lane);
            cvt_weight<0>(xa_w_o + (size_t)i * 1048576, 1024, 1024, 0, 1024, WB + WO_XA_O + (size_t)i * 1048576, 0, nullptr, nullptr, 1.f, scr, rot, NGW, lane);
            cvt_weight<1>(ffn_w_in + (size_t)i * 1024 * 5632, 1024, 5632, 0, 2816, WB + WO_FF_IN + (size_t)i * 5632 * 1024, 0, n_ffn_pre + i * DM, nullptr, 1.f, scr, rot, NGW, lane);
            cvt_weight<2>(ffn_w_in + (size_t)i * 1024 * 5632, 1024, 5632, 2816, 2816, WB + WO_FF_IN + (size_t)i * 5632 * 1024, 0, n_ffn_pre + i * DM, nullptr, 1.f, scr, rot, NGW, lane);
            cvt_weight<0>(ffn_w_out + (size_t)i * 2816 * 1024, 2816, 1024, 0, 1024, WB + WO_FF_OUT + (size_t)i * 1024 * 2816, 0, nullptr, nullptr, 1.f, scr, rot, NGW, lane);
        }
        for (int e = bx * 512 + tid; e < SEQ * 128; e += G * 512) {
            const int t = e >> 7, d = e & 127;
            const double invf = exp2(-(double)d * (13.287712379549449 / 128.0));
            double rev = (double)t * invf * 0.15915494309189535; rev -= floor(rev);
            const float c = __builtin_amdgcn_cosf((float)rev), s = __builtin_amdgcn_sinf((float)rev);
            cosN[e] = c; sinN[e] = s; cosT[(size_t)d * SEQ + t] = c; sinT[(size_t)d * SEQ + t] = s;
        }
        for (int e = bx * 512 + tid; e < (int)(2 * MiB / 16); e += G * 512) ((u32x4*)(GAS u32x4*)(opq(ws) + WS_XCH))[e] = (u32x4){0u, 0u, 0u, 0u};
        rows_to_bf16(x_in, XB, RSTD, NTOK, nullptr, gw, NGW, lane);
        rows_to_bf16(mem, MEMB, MRSTD, NMEM, nullptr, gw, NGW, lane);
    }
    GRID_BAR();
    {
        pg8::Gemm g = pg8::mk_gemm(MEMB, WB + WO_XA_K, 1024, 1024, 1024, 16, 16, 0, 256 * 1024, 0, 30);
        pg8::StaticOrder S; S.init(16, 16, G, bx);
        pg8::EpiStore E{KMEM, 4096, MRSTD, nullptr, 30, 0};
        pg8::gemm_phase(lds, g, S, E);
    }
    {
        pg8::Gemm g = pg8::mk_gemm(MEMB, WB + WO_XA_V, 1024, 1024, 1024, 16, 16, 0, 256 * 1024, 0, 30);
        pg8::StaticOrder S; S.init(16, 16, G, bx);
        pg8::EpiStore E{VTMEM, 4096, MRSTD, nullptr, 30, 0};
        pg8::gemm_phase(lds, g, S, E);
    }
    GRID_BAR();

    unsigned ggen = 0;
    const bool same_xcd = __builtin_popcount((unsigned)__builtin_amdgcn_readfirstlane(xb_ld(ctl + CW_GRP + 64 * (16 + grp)))) == 1;
#define GROUP_BAR() grp_barrier(ctl + CW_GRP + 64 * grp, ggen, same_xcd)
#define SCRB ((unsigned char*)(opq(ws) + WS_MB + (size_t)grp * (40 * MiB)))
#define SCR_ROWS(off, ld) ((bf16_t*)(SCRB + (off)) - (size_t)grp * SEQ * (ld))
#define SCR_BAT(off, per) ((bf16_t*)(SCRB + (off)) - (size_t)grp * (per))
#define XCH_P(rowoff) ((unsigned long long*)(GAS unsigned long long*)(opq(ws) + WS_XCH) + (size_t)(rowoff) * 4)
static_assert(pg8::WGM * 4 * pg8::NXCD == 256, "fused post-norm exchange: with 256 workgroups, WGM * nN(=4) units per (XCD slice, round) must be exactly one 8-panel group, so that a row panel's four column tiles are always dealt in the SAME round (else the owners wait for each other across rounds: deadlock until the spin cap)");
#define FUSED_OUT(GDESC, NM, SUB, PBASE, ROWOFF, GPOST, OUT32) do { \
        pg8::Gemm g = pg8::mk_gemm GDESC; pg8::GroupOrder S; S.init(true, 16, 4, 4, 4, grp, wg16); \
        pg8::EpiNormRes E{XB + (size_t)(ROWOFF) * DM, XB + (size_t)(ROWOFF) * DM, (OUT32), RSTD + (size_t)(ROWOFF) * 4, (GPOST), XCH_P(ROWOFF), (unsigned)((SUB) + 1), lds + SMX_OFF}; \
        pg8::gemm_phase(lds, g, S, E); } while (0)
#pragma unroll 1
    for (int layer = 0; layer < DEPTH; ++layer) {
        const int kind = layer % 3, j = layer / 3;
        if (kind == 0) {
            bf16_t* DP = SCR_ROWS(0, 1024);
            pool_pre(XB, RSTD, n_mix_pre + layer * DM, DP, 64 * grp + wg16, 64 * grp + 64, 16, tid);
            GROUP_BAR();
            FUSED_OUT((DP, WB + WO_POOL + (size_t)j * 262144, 1024, 256, 256, 256, 4, 256, 65536, 0, 30), 256, layer * 3, 0, 0, n_mix_post + layer * DM, nullptr);
        } else if (kind == 1) {
            bf16_t* QK = SCR_ROWS(0, 2048); bf16_t* VT = SCR_BAT(16 * MiB, (size_t)1024 * LDT); bf16_t* AO = SCR_ROWS(25 * MiB, 1024);
            {
                pg8::Gemm g = pg8::mk_gemm(XB, WB + WO_SB_QK, 1024, 1024, 1024, 256, 8, 0, 256 * 1024, 0, 30);
                pg8::GroupOrder S; S.init(true, 16, 8, 4, 4, grp, wg16);
                pg8::EpiStore E{QK, 2048, RSTD, nullptr, 30, 0};
                pg8::gemm_phase(lds, g, S, E);
            }
            {
                pg8::Gemm g = pg8::mk_gemm(WB + WO_SB_V, XB, 1024, 1024, 1024, 4, 256, 0, 256 * 1024, 0, 30);
                pg8::GroupOrder S; S.init(false, 16, 4, 4, 4, grp, wg16);
                pg8::EpiStore E{VT, LDT, nullptr, RSTD, 4, (long)1024 * LDT};
                pg8::gemm_phase(lds, g, S, E);
            }
            GROUP_BAR();
            sb_attention(QK, VT, AO, lds, vcu, G, tid);
            GROUP_BAR();
            FUSED_OUT((AO, WB + WO_SB_O, 1024, 1024, 1024, 256, 4, 0, 256 * 1024, 0, 30), 256, layer * 3, 0, 0, n_mix_post + layer * DM, nullptr);
        } else {
            bf16_t* QKn = (bf16_t*)X; bf16_t* KVT = SCR_BAT(0, (size_t)2048 * LDR); bf16_t* RO = SCR_ROWS(17 * MiB, 2048);
            bf16_t* SC = (bf16_t*)(GAS bf16_t*)(opq(ws) + WS_SC); float* GNS = (float*)(GAS float*)(opq(ws) + WS_MEMB);
            {
                pg8::Gemm g = pg8::mk_gemm(XB, WB + WO_RT_QK, 1024, 1024, 1024, 256, 8, 0, 256 * 1024, 0, 30);
                pg8::GroupOrder S; S.init(true, 16, 8, 4, 4, grp, wg16);
                pg8::EpiRetQK E{QKn, 2048, RSTD, cosN, sinN};
                pg8::gemm_phase(lds, g, S, E);
            }
            {
                pg8::Gemm g = pg8::mk_gemm(WB + WO_RT_KV, XB, 1024, 1024, 1024, 8, 256, 0, 256 * 1024, 0, 30);
                pg8::GroupOrder S; S.init(false, 16, 8, 4, 4, grp, wg16);
                pg8::EpiRetKVT E{KVT, RSTD};
                pg8::gemm_phase(lds, g, S, E);
            }
            GROUP_BAR();
            ret_scores(QKn, SC, 256 * grp + wg16 * 8 + wave, 256 * grp + 256, 128, lane);
            GROUP_BAR();
            ret_scan(QKn, KVT, SC, RO, GNS, lds, vcu, G, tid);
            GROUP_BAR();
            {
                pg8::Gemm g = pg8::mk_gemm(XB, WB + WO_RT_G, 1024, 1024, 1024, 256, 8, 0, 256 * 1024, 0, 30);
                pg8::GroupOrder S; S.init(true, 16, 8, 4, 4, grp, wg16);
                pg8::EpiRetGate E{RO, 2048, RSTD, GNS, ret_gn};
                pg8::gemm_phase(lds, g, S, E);
            }
            GROUP_BAR();
            FUSED_OUT((RO, WB + WO_RT_O, 2048, 2048, 2048, 256, 4, 0, 256 * 2048, 0, 30), 256, layer * 3, 0, 0, n_mix_post + layer * DM, nullptr);
        }
        {
            bf16_t* P = SCR_ROWS(0, 1024); bf16_t* MT = SCR_BAT(34 * MiB, (size_t)1024 * 1024); bf16_t* NT = SCR_BAT(36 * MiB, (size_t)1024 * 1024);
            {
                pg8::Gemm g{KMEM + (size_t)layer * 1024, WB + WO_XA_Q + (size_t)layer * 1048576, 4096, 1024, 256, 64, 4, 2, 30, 256, (long)256 * 4096, 0, 0, 256, 0, (long)256 * 1024, 0};
                pg8::GroupOrder S; S.init(true, 4, 4, 4, 4, grp, wg16);
                pg8::EpiStore E{MT, 1024, nullptr, nullptr, 30, 0};
                pg8::gemm_phase(lds, g, S, E);
            }
            {
                pg8::Gemm g{WB + WO_XA_O + (size_t)layer * 1048576, VTMEM + (size_t)layer * 1024, 1024, 4096, 256, 4, 64, 30, 2, (long)256 * 1024, 0, 256, 0, 0, 0, 256, (long)256 * 4096};
                pg8::GroupOrder S; S.init(false, 4, 4, 4, 4, grp, wg16);
                pg8::EpiStore E{NT, 1024, nullptr, nullptr, 2, (long)1024 * 1024};
                pg8::gemm_phase(lds, g, S, E);
            }
            GROUP_BAR();
            {
                pg8::Gemm g = pg8::mk_gemm(XB, MT, 1024, 1024, 1024, 256, 4, 0, 256 * 1024, (long)1024 * 1024, 4);
                pg8::GroupOrder S; S.init(true, 16, 4, 4, 4, grp, wg16);
                pg8::EpiSoftmax E{P, 1024, (LAS float*)(lds + SMX_OFF), RSTD};
                pg8::gemm_phase(lds, g, S, E);
            }
            GROUP_BAR();
            FUSED_OUT((P, NT, 1024, 1024, 1024, 256, 4, 0, 256 * 1024, (long)1024 * 1024, 4), 256, layer * 3 + 1, 0, 0, n_xa_post + layer * DM, nullptr);
            GROUP_BAR();
        }
        {
            bf16_t* ACT = SCR_ROWS(0, DFF);
            {
                pg8::Gemm g = pg8::mk_gemm(XB, WB + WO_FF_IN + (size_t)layer * 5632 * 1024, 1024, 1024, 1024, 256, 22, 0, 256 * 1024, 0, 30);
                pg8::GroupOrder S; S.init(true, 16, 20, 4, 4, grp, wg16); S.tail0 = 20; S.rounds = 22;
                pg8::EpiSwiglu E{ACT, DFF, RSTD};
                pg8::gemm_phase(lds, g, S, E);
            }
            GROUP_BAR();
            FUSED_OUT((ACT, WB + WO_FF_OUT + (size_t)layer * 1024 * 2816, DFF, DFF, DFF, 256, 4, 0, (long)256 * DFF, 0, 30), 256, layer * 3 + 2, 0, 0, n_ffn_post + layer * DM, (layer == DEPTH - 1 ? X : nullptr));
            GROUP_BAR();
        }
    }
}

extern "C" void kernel_launch(void* const* d_in, const int* in_sizes, int n_in, void* d_out, int out_size, void* d_ws, size_t ws_size, hipStream_t stream) {
    static int grid = 0;
    if (grid == 0) {
        if (n_in != 21 || in_sizes[0] != NTOK * DM || out_size != NTOK * DM || ws_size < WS_END) {
            fprintf(stderr, "kernel_launch: unexpected problem (n_in %d, in0 %d, out %d, ws %zu, need %zu); nothing launched\n", n_in, n_in > 0 ? in_sizes[0] : -1, out_size, ws_size, (size_t)WS_END); grid = -1; return; }
        int dev = 0, cus = 0, per_cu = 0;
        if (hipGetDevice(&dev) != hipSuccess || hipDeviceGetAttribute(&cus, hipDeviceAttributeMultiprocessorCount, dev) != hipSuccess) { grid = -1; return; }
        if (hipFuncSetAttribute((const void*)fwd_kernel, hipFuncAttributeMaxDynamicSharedMemorySize, LDS_BYTES) != hipSuccess) { fprintf(stderr, "kernel_launch: hipFuncSetAttribute failed\n"); grid = -1; return; }
        if (hipOccupancyMaxActiveBlocksPerMultiprocessor(&per_cu, (const void*)fwd_kernel, 512, LDS_BYTES) != hipSuccess || per_cu < 1)
            fprintf(stderr, "kernel_launch: note: occupancy query reports %d workgroups per CU\n", per_cu);
        (void)hipGetLastError();
        if (cus != 256) { fprintf(stderr, "kernel_launch: built for 256 CUs (one 256-unit GEMM round per workgroup in the fused post-norm phases), device has %d; nothing launched\n", cus); grid = -1; return; }
        grid = cus;
    }
    if (grid < 0) return;
    if (hipMemsetAsync((char*)d_ws + WS_CTL, 0, CTL_ZERO_BYTES, stream) != hipSuccess) return;
    Args a{};
    for (int i = 0; i < 21; ++i) a.in[i] = (const float*)d_in[i];
    a.out = (float*)d_out; a.ws = (unsigned char*)d_ws;
    hipLaunchKernelGGL(fwd_kernel, dim3(grid), dim3(512), LDS_BYTES, stream, a);
}
```

```cpp
#include <hip/hip_runtime.h>
#include <cstdio>
#include <cstdint>

#define LAS __attribute__((address_space(3)))
#define GAS __attribute__((address_space(1)))
typedef unsigned short bf16_t;
typedef short bf16x8 __attribute__((ext_vector_type(8)));
typedef short bf16x4 __attribute__((ext_vector_type(4)));
typedef float f32x4 __attribute__((ext_vector_type(4)));
typedef float f32x2 __attribute__((ext_vector_type(2)));
typedef float f32x16 __attribute__((ext_vector_type(16)));
typedef unsigned u32x4 __attribute__((ext_vector_type(4)));
typedef unsigned u32x2 __attribute__((ext_vector_type(2)));
typedef __bf16 bf16x2_t __attribute__((ext_vector_type(2)));
#define DI __device__ __forceinline__

constexpr int NB = 16, SEQ = 4096, DM = 1024, NTOK = NB * SEQ, DEPTH = 4, DFF = 2816, MEML = 256, NMEM = NB * MEML;
constexpr int LDT = 4160;
constexpr int LDR = 4104;
constexpr float RMS_EPS = 1e-6f, GN_EPS = 1e-5f, LOG2E = 1.4426950408889634f;

constexpr size_t MiB = 1u << 20;
constexpr size_t WS_CTL = 0, CTL_ZERO_BYTES = 64 * 1024;
constexpr size_t WS_RSTD = 1 * MiB;
constexpr size_t WS_MRSTD = WS_RSTD + 256 * 1024;
constexpr size_t WS_ROPE = 2 * MiB;
constexpr size_t WS_MEMB = 10 * MiB;
constexpr size_t WS_KMEM = 18 * MiB;
constexpr size_t WS_VTMEM = 50 * MiB;
constexpr size_t WS_WB = 82 * MiB;
constexpr size_t WS_XB = 210 * MiB;
constexpr size_t WS_MB = 338 * MiB;
constexpr size_t WS_R = 466 * MiB;
constexpr size_t WS_XCH = WS_R + 520 * MiB;
constexpr size_t WS_SSQ = WS_XCH + 2 * MiB;
constexpr size_t WS_SC = WS_SSQ + 1 * MiB;
constexpr size_t WS_END = WS_SC + 32 * MiB;

constexpr size_t WO_POOL = 0;
constexpr size_t WO_SB_QK = WO_POOL + 2 * 262144;
constexpr size_t WO_SB_V = WO_SB_QK + 2048 * 1024;
constexpr size_t WO_SB_O = WO_SB_V + 1024 * 1024;
constexpr size_t WO_RT_QK = WO_SB_O + 1024 * 1024;
constexpr size_t WO_RT_KV = WO_RT_QK + 2048 * 1024;
constexpr size_t WO_RT_G = WO_RT_KV + 3072 * 1024;
constexpr size_t WO_RT_O = WO_RT_G + 2048 * 1024;
constexpr size_t WO_XA_Q = WO_RT_O + 1024 * 2048;
constexpr size_t WO_XA_K = WO_XA_Q + 4 * 1024 * 1024;
constexpr size_t WO_XA_V = WO_XA_K + 4 * 1024 * 1024;
constexpr size_t WO_XA_O = WO_XA_V + 4 * 1024 * 1024;
constexpr size_t WO_FF_IN = WO_XA_O + 4 * 1024 * 1024;
constexpr size_t WO_FF_OUT = WO_FF_IN + 4 * (size_t)5632 * 1024;
constexpr size_t WO_END = WO_FF_OUT + 4 * (size_t)1024 * 2816;
static_assert(WO_END * 2 <= 128 * MiB, "weights fit");

constexpr int CW_BAR = 4096;
constexpr int CW_GRP = 8192;

constexpr int RING_BYTES = 131072;
constexpr int SMX_OFF = RING_BYTES;
constexpr int MISC_OFF = RING_BYTES + 16384;
constexpr int RT_OFF = 149504;
constexpr int LDS_BYTES = 157696;

DI unsigned cvtpk(float lo, float hi) { f32x2 v = {lo, hi}; bf16x2_t b = __builtin_convertvector(v, bf16x2_t); return __builtin_bit_cast(unsigned, b); }
DI float bf2f(unsigned short b) { return __uint_as_float(((unsigned)b) << 16); }
DI float bflo(unsigned w) { return __uint_as_float(w << 16); }
DI float bfhi(unsigned w) { return __uint_as_float(w & 0xffff0000u); }
DI float xsum16(float v) { const auto r = __builtin_amdgcn_permlane16_swap(__float_as_uint(v), __float_as_uint(v), false, false); return __uint_as_float(r[0]) + __uint_as_float(r[1]); }
DI float xsum32(float v) { const auto r = __builtin_amdgcn_permlane32_swap(__float_as_uint(v), __float_as_uint(v), false, false); return __uint_as_float(r[0]) + __uint_as_float(r[1]); }
DI float xmax16(float v) { const auto r = __builtin_amdgcn_permlane16_swap(__float_as_uint(v), __float_as_uint(v), false, false); return fmaxf(__uint_as_float(r[0]), __uint_as_float(r[1])); }
DI float xmax32(float v) { const auto r = __builtin_amdgcn_permlane32_swap(__float_as_uint(v), __float_as_uint(v), false, false); return fmaxf(__uint_as_float(r[0]), __uint_as_float(r[1])); }
DI float xchg32(float v, int upper) { const auto r = __builtin_amdgcn_permlane32_swap(__float_as_uint(v), __float_as_uint(v), false, false); return __uint_as_float(upper ? r[0] : r[1]); }
DI float rowsum16(float v) {
    v += __uint_as_float(__builtin_amdgcn_update_dpp(0, __float_as_uint(v), 0x128, 0xf, 0xf, false));
    v += __uint_as_float(__builtin_amdgcn_update_dpp(0, __float_as_uint(v), 0x124, 0xf, 0xf, false));
    v += __uint_as_float(__builtin_amdgcn_update_dpp(0, __float_as_uint(v), 0x122, 0xf, 0xf, false));
    v += __uint_as_float(__builtin_amdgcn_update_dpp(0, __float_as_uint(v), 0x121, 0xf, 0xf, false));
    return v; }
DI float wave_sum(float v) { return xsum32(xsum16(rowsum16(v))); }
DI float ex2(float x) { return __builtin_amdgcn_exp2f(x); }
DI float lg2(float x) { return __builtin_amdgcn_logf(x); }
DI float rstd_of(const float* ssq, int row) { const f32x4 p = *(const f32x4*)(ssq + (size_t)row * 4); return __builtin_amdgcn_rsqf(((p[0] + p[1]) + (p[2] + p[3])) * (1.0f / DM) + RMS_EPS); }
DI float rstd_q(const f32x4 p) { return __builtin_amdgcn_rsqf(((p[0] + p[1]) + (p[2] + p[3])) * (1.0f / DM) + RMS_EPS); }
DI float silu(float g) { return g * __builtin_amdgcn_rcpf(1.0f + ex2(-g * LOG2E)); }
#define LDS_WAIT() asm volatile("s_waitcnt lgkmcnt(0)" ::: "memory")
#define VM_WAIT() asm volatile("s_waitcnt vmcnt(0)" ::: "memory")

namespace pg8 {
constexpr int BM = 256, BK = 64, HALF = 128, HTB = HALF * BK * 2, STAGE_BYTES = 8 * HTB, NXCD = 8, WGM = 8;
DI int lds_byte(int r, int c) { const int st = (r >> 4) * 2 + (c >> 5), rr = r & 15, cc = c & 31, ob = rr * 64 + cc * 2; return st * 1024 + (ob ^ (((ob >> 9) & 1) << 5)); }
DI void stage_rc(int b, int& R, int& C) { const int st = b / 1024, sb = b % 1024, swz = sb ^ (((sb >> 9) & 1) << 5); R = (st >> 1) * 16 + swz / 64; C = (st & 1) * 32 + (swz % 64) / 2; }
DI int perm32(int rho) { const int n = rho >> 4, i = rho & 15; return 8 * (i >> 2) + 4 * n + (i & 3); }
struct Unit { int pm, pn; };
struct Gemm { const bf16_t* A; const bf16_t* B; int lda, ldb, K, nM, nN, msh, nsh; long a_ml, a_mh, a_nl, a_nh, b_ml, b_mh, b_nl, b_nh;
    DI const char* aptr(int pm, int pn) const { return (const char*)(A + (size_t)(pm & ((1 << msh) - 1)) * a_ml + (size_t)(pm >> msh) * a_mh + (size_t)(pn & ((1 << nsh) - 1)) * a_nl + (size_t)(pn >> nsh) * a_nh); }
    DI const char* bptr(int pm, int pn) const { return (const char*)(B + (size_t)(pm & ((1 << msh) - 1)) * b_ml + (size_t)(pm >> msh) * b_mh + (size_t)(pn & ((1 << nsh) - 1)) * b_nl + (size_t)(pn >> nsh) * b_nh); } };
DI Gemm mk_gemm(const bf16_t* A, const bf16_t* B, int lda, int ldb, int K, int nM, int nN, long a_pn, long b_pn, long b_z, int zshift) {
    return Gemm{A, B, lda, ldb, K, nM, nN, zshift, 30, 256L * lda, (256L * lda) << zshift, a_pn, 0, 0, b_z, b_pn, 0}; }
struct StaticOrder {
    int nM, nN, nwg, G, c;
    DI void init(int nM_, int nN_, int G_, int c_) { nM = nM_; nN = nN_; nwg = nM * nN; G = G_; c = c_; }
    DI bool next(int i, Unit& u) const {
        const long L = (long)i * G + c; if (L >= nwg) return false;
        int wgid = (int)L; { const int q = nwg / NXCD, r = nwg % NXCD, xcd = wgid % NXCD, off = wgid / NXCD; wgid = (xcd < r ? xcd * (q + 1) : r * (q + 1) + (xcd - r) * q) + off; }
        const int nig = WGM * nN, gid = wgid / nig, fm = gid * WGM, gsz = (nM - fm) < WGM ? (nM - fm) : WGM;
        u.pm = fm + ((wgid % nig) % gsz); u.pn = (wgid % nig) / gsz; return true;
    }
};

template <class Epi, class Sched>
DI void gemm_phase(LAS unsigned char* lds, const Gemm g, const Sched& S, const Epi& E) {
    int tid = threadIdx.x; asm volatile("" : "+v"(tid));
    const int wid = __builtin_amdgcn_readfirstlane(tid >> 6), lane = tid & 63, wr = wid >> 2, wc = wid & 3, fr = lane & 15, fq = lane >> 4;
    const int K = g.K, nt = K / BK;
    unsigned voffA[2], voffB[2];
#pragma unroll
    for (int i = 0; i < 2; ++i) { int R, C; stage_rc(tid * 16 + i * 8192, R, C); const int Rb = (R & ~31) + perm32(R & 31);
        voffA[i] = (unsigned)(R * g.lda + C) * 2u; voffB[i] = (unsigned)(Rb * g.ldb + C) * 2u; }
    const size_t kstep = (size_t)(BK * 2);
    const size_t hstepA = (size_t)HALF * g.lda * 2, hstepB = (size_t)HALF * g.ldb * 2;
    const unsigned ldsw = (unsigned)wid * 1024u;
    const int aoff = lds_byte(wr * 64 + fr, fq * 8), boff = lds_byte(wc * 32 + fr, fq * 8);
#define PG8_SA(b, h) (((b) * 2 + (h)) * HTB)
#define PG8_SB(b, h) ((4 + (b) * 2 + (h)) * HTB)
#define PG8_STAGE(bufoff, gbase, voff) do { _Pragma("unroll") for (int _i = 0; _i < 2; ++_i) \
        __builtin_amdgcn_global_load_lds((const unsigned*)((const char*)(gbase) + (voff)[_i]), (LAS unsigned*)(lds + (bufoff) + ldsw + _i * 8192), 16, 0, 0); } while (0)
#define PG8_LDA(dst, b, h) do { _Pragma("unroll") for (int m = 0; m < 4; ++m) _Pragma("unroll") for (int k = 0; k < 2; ++k) dst[m][k] = *(const LAS bf16x8*)(lds + PG8_SA(b, h) + aoff + m * 2048 + k * 1024); } while (0)
#define PG8_LDB(dst, b, h) do { _Pragma("unroll") for (int n = 0; n < 2; ++n) _Pragma("unroll") for (int k = 0; k < 2; ++k) dst[n][k] = *(const LAS bf16x8*)(lds + PG8_SB(b, h) + boff + n * 2048 + k * 1024); } while (0)
#define PG8_MMA(ai, bj, At, Bt) do { __builtin_amdgcn_s_setprio(1); _Pragma("unroll") for (int m = 0; m < 4; ++m) _Pragma("unroll") for (int n = 0; n < 2; ++n) _Pragma("unroll") for (int k = 0; k < 2; ++k) \
        acc[ai][bj][m][n] = __builtin_amdgcn_mfma_f32_16x16x32_bf16(Bt[n][k], At[m][k], acc[ai][bj][m][n], 0, 0, 0); __builtin_amdgcn_s_setprio(0); } while (0)
#define PG8_WAIT_V(n) asm volatile("s_waitcnt vmcnt(" #n ")" ::: "memory")
#define PG8_WAIT_L(n) asm volatile("s_waitcnt lgkmcnt(" #n ")" ::: "memory")
#define PG8_BAR __builtin_amdgcn_s_barrier()
#define PG8_SCHED __builtin_amdgcn_sched_barrier(0)
    Unit cur, nxt; int ui = 0;
    if (!S.next(0, cur)) return;
    f32x4 acc[2][2][4][2];
#pragma unroll
    for (int a = 0; a < 2; ++a)
#pragma unroll
        for (int b = 0; b < 2; ++b)
#pragma unroll
            for (int m = 0; m < 4; ++m)
#pragma unroll
                for (int n = 0; n < 2; ++n) acc[a][b][m][n] = (f32x4){0.f, 0.f, 0.f, 0.f};
    bf16x8 At[4][2], B0[2][2], B1[2][2];
    const char* cA = g.aptr(cur.pm, cur.pn);
    const char* cB = g.bptr(cur.pm, cur.pn);
    LAS float* rtab = (LAS float*)(lds + RT_OFF);
    const float* rsp = nullptr;
    if constexpr (Epi::ROWSTAT) { rsp = E.statp() ? E.statp() : (const float*)g.A;
        __builtin_amdgcn_global_load_lds((const unsigned*)(rsp + (size_t)(E.stati(cur) * BM + (wid & 3) * 64 + lane) * 4), (LAS unsigned*)(rtab + (wid & 3) * 256), 16, 0, 0); }
    PG8_STAGE(PG8_SB(0, 0), cB, voffB); PG8_STAGE(PG8_SB(0, 1), cB + hstepB, voffB); PG8_STAGE(PG8_SA(0, 0), cA, voffA); PG8_STAGE(PG8_SA(0, 1), cA + hstepA, voffA);
    if (wr == 1) PG8_BAR;
    PG8_WAIT_V(2); PG8_BAR;
    PG8_STAGE(PG8_SB(1, 0), cB + kstep, voffB); PG8_STAGE(PG8_SA(1, 0), cA + kstep, voffA); PG8_STAGE(PG8_SB(1, 1), cB + hstepB + kstep, voffB);
    PG8_WAIT_V(6); PG8_BAR;
    for (;;) {
        const bool has_next = S.next(ui + 1, nxt);
        const char* nA = has_next ? g.aptr(nxt.pm, nxt.pn) : cA;
        const char* nB = has_next ? g.bptr(nxt.pm, nxt.pn) : cB;
        for (int t = 0; t < nt; t += 2) {
            const bool last = (t == nt - 2);
            const char* a1 = cA + (size_t)(t + 1) * kstep;
            const char* a2 = last ? nA : cA + (size_t)(t + 2) * kstep; const char* b2 = last ? nB : cB + (size_t)(t + 2) * kstep;
            const char* a3 = a2 + kstep; const char* b3 = b2 + kstep;
            PG8_LDB(B0, 0, 0); PG8_LDB(B1, 0, 1); PG8_SCHED; PG8_LDA(At, 0, 0); PG8_STAGE(PG8_SA(1, 1), a1 + hstepA, voffA);
            PG8_WAIT_V(8); PG8_WAIT_L(0); PG8_BAR; PG8_MMA(0, 0, At, B0); PG8_MMA(0, 1, At, B1); PG8_BAR; PG8_SCHED;
            PG8_LDA(At, 0, 1); PG8_STAGE(PG8_SB(0, 0), b2, voffB); PG8_STAGE(PG8_SB(0, 1), b2 + hstepB, voffB); PG8_STAGE(PG8_SA(0, 0), a2, voffA);
            PG8_WAIT_V(8); PG8_WAIT_L(0); PG8_BAR; PG8_MMA(1, 0, At, B0); PG8_MMA(1, 1, At, B1); PG8_BAR; PG8_SCHED;
            PG8_LDB(B0, 1, 0); PG8_LDB(B1, 1, 1); PG8_SCHED; PG8_LDA(At, 1, 0); PG8_STAGE(PG8_SA(0, 1), a2 + hstepA, voffA);
            PG8_WAIT_V(8); PG8_WAIT_L(0); PG8_BAR; PG8_MMA(0, 0, At, B0); PG8_MMA(0, 1, At, B1); PG8_BAR; PG8_SCHED;
            PG8_LDA(At, 1, 1); PG8_STAGE(PG8_SB(1, 0), b3, voffB); PG8_STAGE(PG8_SB(1, 1), b3 + hstepB, voffB); PG8_STAGE(PG8_SA(1, 0), a3, voffA);
            PG8_WAIT_V(8); PG8_WAIT_L(0); PG8_BAR; PG8_MMA(1, 0, At, B0); PG8_MMA(1, 1, At, B1); PG8_BAR; PG8_SCHED;
        }
        if (wr == 0) PG8_BAR;
        if constexpr (!Epi::AFTER_DRAIN) { int fr_ = fr, fq_ = fq; asm volatile("" : "+v"(fr_), "+v"(fq_));
          if constexpr (Epi::ROWSTAT) __builtin_amdgcn_global_load_lds((const unsigned*)(rsp + (size_t)((has_next ? E.stati(nxt) : E.stati(cur)) * BM + (wid & 3) * 64 + lane) * 4), (LAS unsigned*)(rtab + ((ui + 1) & 1) * 1024 + (wid & 3) * 256), 16, 0, 0);
          E(acc, cur, wr, wc, fr_, fq_, rtab + (ui & 1) * 1024); }
        if (!has_next) break;
#pragma unroll
        for (int a = 0; a < 2; ++a)
#pragma unroll
            for (int b = 0; b < 2; ++b)
#pragma unroll
                for (int m = 0; m < 4; ++m)
#pragma unroll
                    for (int n = 0; n < 2; ++n) acc[a][b][m][n] = (f32x4){0.f, 0.f, 0.f, 0.f};
        cur = nxt; cA = nA; cB = nB; ++ui;
        if (wr == 1) PG8_BAR;
    }
    PG8_WAIT_V(0);
    PG8_BAR;
    if constexpr (Epi::AFTER_DRAIN) { int fr_ = fr, fq_ = fq; asm volatile("" : "+v"(fr_), "+v"(fq_)); E.fused(acc, cur, wr, wc, fr_, fq_, lds, wid, lane); }
#undef PG8_SA
#undef PG8_SB
#undef PG8_STAGE
#undef PG8_LDA
#undef PG8_LDB
#undef PG8_MMA
#undef PG8_WAIT_V
#undef PG8_WAIT_L
#undef PG8_BAR
#undef PG8_SCHED
}

struct RoundOrder : StaticOrder { int round; DI bool next(int i, Unit& u) const { return i == 0 ? StaticOrder::next(round, u) : false; } };
struct GroupOrder {
    int grp, w, TT, PB, TB, ntb, rounds; bool tokM; int tail0 = 1 << 30;
    DI void init(bool tokM_, int TT_, int nOther, int PB_, int TB_, int grp_, int w_) { tokM = tokM_; TT = TT_; PB = PB_; TB = TB_; ntb = nOther / TB_; rounds = TT_ * nOther / 16; grp = grp_; w = w_; }
    DI bool next(int i, Unit& u) const {
        if (i >= rounds) return false;
        if (i >= tail0) { const int bt8 = TT * grp + (i - tail0) * 8 + (w & 7), ot2 = ntb * TB + (w >> 3); if (tokM) { u.pm = bt8; u.pn = ot2; } else { u.pm = ot2; u.pn = bt8; } return true; }
        const int pb = i / ntb, tb = i - pb * ntb, bt = TT * grp + pb * PB + (w % PB), ot = tb * TB + (w / PB);
        if (tokM) { u.pm = bt; u.pn = ot; } else { u.pm = ot; u.pn = bt; }
        return true; }
};
typedef f32x4 Acc[2][2][4][2];

struct EpiStore {
    static constexpr bool AFTER_DRAIN = false; static constexpr bool ROWSTAT = true;
    bf16_t* O; long ldc; const float* rs; const float* cs; int csh; long cbs;
    DI const float* statp() const { return rs ? rs : cs; }   DI int stati(const Unit& u) const { return rs ? u.pm : u.pn; }
    DI void operator()(const Acc& acc, const Unit& u, int wr, int wc, int fr, int fq, const LAS float* rt) const {
        const int row0 = u.pm * BM + wr * 64 + fr;
        const long cbase = (long)(u.pn >> csh) * cbs + (long)(u.pn & ((1 << csh) - 1)) * 256 + wc * 32 + 8 * fq;
        float pr[2][4];
        if (rs) {
#pragma unroll
            for (int ai = 0; ai < 2; ++ai)
#pragma unroll
                for (int m = 0; m < 4; ++m) pr[ai][m] = rstd_q(*(const LAS f32x4*)(rt + 4 * (ai * HALF + wr * 64 + m * 16 + fr))); }
        float csv[2][8];
#pragma unroll
        for (int bj = 0; bj < 2; ++bj) {
            if (cs) {
#pragma unroll
                for (int k = 0; k < 8; ++k) csv[bj][k] = rstd_q(*(const LAS f32x4*)(rt + 4 * (bj * HALF + wc * 32 + 8 * fq + k))); }
            else {
#pragma unroll
                for (int k = 0; k < 8; ++k) csv[bj][k] = 1.f; }
        }
        asm volatile("" ::: "memory");
#pragma unroll
        for (int ai = 0; ai < 2; ++ai)
#pragma unroll
            for (int m = 0; m < 4; ++m) { const int row = row0 + ai * HALF + m * 16; const float r = rs ? pr[ai][m] : 1.f;
                bf16_t* rowp = O + (size_t)row * ldc + cbase;
#pragma unroll
                for (int bj = 0; bj < 2; ++bj) { const f32x4 v0 = acc[ai][bj][m][0], v1 = acc[ai][bj][m][1];
                    u32x4 w; w.x = cvtpk(v0[0] * r * csv[bj][0], v0[1] * r * csv[bj][1]); w.y = cvtpk(v0[2] * r * csv[bj][2], v0[3] * r * csv[bj][3]);
                    w.z = cvtpk(v1[0] * r * csv[bj][4], v1[1] * r * csv[bj][5]); w.w = cvtpk(v1[2] * r * csv[bj][6], v1[3] * r * csv[bj][7]);
                    *(u32x4*)(rowp + bj * HALF) = w; } }
    }
};
struct EpiSwiglu {
    static constexpr bool AFTER_DRAIN = false; static constexpr bool ROWSTAT = true;
    bf16_t* O; long ldc; const float* rs;
    DI const float* statp() const { return rs; }   DI int stati(const Unit& u) const { return u.pm; }
    DI void operator()(const Acc& acc, const Unit& u, int wr, int wc, int fr, int fq, const LAS float* rt) const {
        const int row0 = u.pm * BM + wr * 64 + fr; const int col = u.pn * 128 + wc * 32 + 8 * fq;
        float pr[2][4];
#pragma unroll
        for (int ai = 0; ai < 2; ++ai)
#pragma unroll
            for (int m = 0; m < 4; ++m) pr[ai][m] = rstd_q(*(const LAS f32x4*)(rt + 4 * (ai * HALF + wr * 64 + m * 16 + fr)));
        asm volatile("" ::: "memory");
#pragma unroll
        for (int ai = 0; ai < 2; ++ai)
#pragma unroll
            for (int m = 0; m < 4; ++m) { const int row = row0 + ai * HALF + m * 16; const float r = pr[ai][m]; const float rc = r * -LOG2E, r2i = __builtin_amdgcn_rcpf(r * r);
                const f32x4 g0 = acc[ai][0][m][0], g1 = acc[ai][0][m][1], u0 = acc[ai][1][m][0], u1 = acc[ai][1][m][1];
                const f32x4 x0 = g0 * rc, x1 = g1 * rc, p0 = g0 * u0, p1 = g1 * u1;
                f32x4 e0, e1;
#pragma unroll
                for (int i = 0; i < 4; ++i) { e0[i] = ex2(x0[i]); e1[i] = ex2(x1[i]); }
                const f32x4 d0 = e0 * r2i + r2i, d1 = e1 * r2i + r2i;
                f32x4 q0, q1;
#pragma unroll
                for (int i = 0; i < 4; ++i) { q0[i] = __builtin_amdgcn_rcpf(d0[i]); q1[i] = __builtin_amdgcn_rcpf(d1[i]); }
                const f32x4 o0 = p0 * q0, o1 = p1 * q1;
                u32x4 w; w.x = cvtpk(o0[0], o0[1]); w.y = cvtpk(o0[2], o0[3]); w.z = cvtpk(o1[0], o1[1]); w.w = cvtpk(o1[2], o1[3]);
                *(u32x4*)(O + (size_t)row * ldc + col) = w; }
    }
};
struct EpiSoftmax {
    static constexpr bool AFTER_DRAIN = false; static constexpr bool ROWSTAT = true;
    bf16_t* O; long ldc; LAS float* tab; const float* rs;
    DI const float* statp() const { return rs; }   DI int stati(const Unit& u) const { return u.pm; }
    DI void operator()(Acc& acc, const Unit& u, int wr, int wc, int fr, int fq, const LAS float* rt) const {
        float mw[2][4];
        float pr[2][4];
        if (rs) {
#pragma unroll
            for (int ai = 0; ai < 2; ++ai)
#pragma unroll
                for (int m = 0; m < 4; ++m) pr[ai][m] = rstd_q(*(const LAS f32x4*)(rt + 4 * (ai * HALF + wr * 64 + m * 16 + fr))); }
        asm volatile("" ::: "memory");
#pragma unroll
        for (int ai = 0; ai < 2; ++ai)
#pragma unroll
            for (int m = 0; m < 4; ++m) {
                const float rsc = rs ? pr[ai][m] : 1.f;
                float mx = -INFINITY;
#pragma unroll
                for (int bj = 0; bj < 2; ++bj)
#pragma unroll
                    for (int n = 0; n < 2; ++n) { const f32x4 v = acc[ai][bj][m][n]; mx = fmaxf(fmaxf(mx, fmaxf(v[0], v[1])), fmaxf(v[2], v[3])); }
                mx = xmax32(xmax16(mx)) * rsc;
                const float nm = -mx;
                float s = 0.f;
#pragma unroll
                for (int bj = 0; bj < 2; ++bj)
#pragma unroll
                    for (int n = 0; n < 2; ++n)
#pragma unroll
                        for (int i = 0; i < 4; ++i) { const float p = ex2(__builtin_fmaf(acc[ai][bj][m][n][i], rsc, nm)); acc[ai][bj][m][n][i] = p; s += p; }
                s = xsum32(xsum16(s));
                mw[ai][m] = mx;
                const int r = ai * HALF + wr * 64 + m * 16 + fr;
                if (fq == 0) { tab[(r * 4 + wc) * 2] = mx; tab[(r * 4 + wc) * 2 + 1] = s; }
            }
        LDS_WAIT(); __builtin_amdgcn_s_barrier(); asm volatile("" ::: "memory");
        const int row0 = u.pm * BM + wr * 64 + fr; const int col = u.pn * BM + wc * 32 + 8 * fq;
#pragma unroll
        for (int ai = 0; ai < 2; ++ai)
#pragma unroll
            for (int m = 0; m < 4; ++m) {
                const int r = ai * HALF + wr * 64 + m * 16 + fr;
                const f32x4 t0 = *(const LAS f32x4*)(tab + r * 8), t1 = *(const LAS f32x4*)(tab + r * 8 + 4);
                const float M = fmaxf(fmaxf(t0[0], t0[2]), fmaxf(t1[0], t1[2]));
                const float L = t0[1] * ex2(t0[0] - M) + t0[3] * ex2(t0[2] - M) + t1[1] * ex2(t1[0] - M) + t1[3] * ex2(t1[2] - M);
                const float f = ex2(mw[ai][m] - M) * __builtin_amdgcn_rcpf(L);
                bf16_t* rowp = O + (size_t)(row0 + ai * HALF + m * 16) * ldc + col;
#pragma unroll
                for (int bj = 0; bj < 2; ++bj) { const f32x4 v0 = acc[ai][bj][m][0] * f, v1 = acc[ai][bj][m][1] * f;
                    u32x4 w; w.x = cvtpk(v0[0], v0[1]); w.y = cvtpk(v0[2], v0[3]); w.z = cvtpk(v1[0], v1[1]); w.w = cvtpk(v1[2], v1[3]);
                    *(u32x4*)(rowp + bj * HALF) = w; }
            }
    }
};
struct EpiRetQK {
    static constexpr bool AFTER_DRAIN = false; static constexpr bool ROWSTAT = true;
    bf16_t* O; long ldc; const float* rs; const float* kt;
    DI const float* statp() const { return rs; }   DI int stati(const Unit& u) const { return u.pm; }
    DI void operator()(const Acc& acc, const Unit& u, int wr, int wc, int fr, int fq, const LAS float* rt) const {
        const int row0 = u.pm * BM + wr * 64 + fr; const int d0 = wc * 32 + 8 * fq, dt0 = wc * 32 + 4 * fq;
        const float lg = lg2(1.0f - ex2(-5.0f - (float)(u.pn & 3))) * (u.pn < 4 ? 1.f : -1.f);
        const f32x4 kh0 = *(const f32x4*)(kt + dt0), kh1 = *(const f32x4*)(kt + dt0 + 16), kl0 = *(const f32x4*)(kt + 128 + dt0), kl1 = *(const f32x4*)(kt + 128 + dt0 + 16);
        float pq[2][4];
#pragma unroll
        for (int ai = 0; ai < 2; ++ai)
#pragma unroll
            for (int m = 0; m < 4; ++m) pq[ai][m] = rstd_q(*(const LAS f32x4*)(rt + 4 * (ai * HALF + wr * 64 + m * 16 + fr)));
#pragma unroll
        for (int ai = 0; ai < 2; ++ai)
#pragma unroll
            for (int m = 0; m < 4; ++m) { const int row = row0 + ai * HALF + m * 16; const int t = row & (SEQ - 1); const float tf = (float)t;
                const float r = pq[ai][m] * ex2((float)(t & 63) * lg);
                bf16_t* rowp = O + (size_t)row * ldc + u.pn * BM + d0;
                float o1[8], o2[8];
#pragma unroll
                for (int n = 0; n < 2; ++n) { const f32x4 kh = n ? kh1 : kh0, kl = n ? kl1 : kl0;
#pragma unroll
                    for (int i = 0; i < 4; ++i) { const float rev = __builtin_fmaf(tf, kl[i], __builtin_amdgcn_fractf(tf * kh[i]));
                        const float c = __builtin_amdgcn_cosf(rev), sn = __builtin_amdgcn_sinf(rev);
                        const float x1 = acc[ai][0][m][n][i] * r, x2 = acc[ai][1][m][n][i] * r; o1[4 * n + i] = x1 * c - x2 * sn; o2[4 * n + i] = x1 * sn + x2 * c; } }
                const bool hsw = (u.pn >= 4) && ((t & 8) != 0);
                u32x4 w; w.x = cvtpk(o1[0], o1[1]); w.y = cvtpk(o1[2], o1[3]); w.z = cvtpk(o1[4], o1[5]); w.w = cvtpk(o1[6], o1[7]); if (hsw) w = (u32x4){w.z, w.w, w.x, w.y}; *(u32x4*)(rowp) = w;
                w.x = cvtpk(o2[0], o2[1]); w.y = cvtpk(o2[2], o2[3]); w.z = cvtpk(o2[4], o2[5]); w.w = cvtpk(o2[6], o2[7]); if (hsw) w = (u32x4){w.z, w.w, w.x, w.y}; *(u32x4*)(rowp + HALF) = w; }
    }
};
struct EpiRetKVT {
    static constexpr bool AFTER_DRAIN = false; static constexpr bool ROWSTAT = true;
    bf16_t* O; const float* cs;
    DI const float* statp() const { return cs; }   DI int stati(const Unit& u) const { return u.pn; }
    DI void operator()(const Acc& acc, const Unit& u, int wr, int wc, int fr, int fq, const LAS float* rt) const {
        const int rl0 = wr * 64 + fr;
        const int tcol = (u.pn & 15) * 256 + wc * 32 + 8 * fq;
        bf16_t* base = O + (size_t)(u.pn >> 4) * 2048 * LDR + (size_t)(u.pm * BM) * LDR + tcol;
        float csv[2][8];
#pragma unroll
        for (int bj = 0; bj < 2; ++bj)
#pragma unroll
            for (int k = 0; k < 8; ++k) csv[bj][k] = rstd_q(*(const LAS f32x4*)(rt + 4 * (bj * HALF + wc * 32 + 8 * fq + k)));
#pragma unroll
        for (int ai = 0; ai < 2; ++ai)
#pragma unroll
            for (int m = 0; m < 4; ++m) { bf16_t* rowp = base + (size_t)(rl0 + ai * HALF + m * 16) * LDR;
#pragma unroll
                for (int bj = 0; bj < 2; ++bj) { const f32x4 v0 = acc[ai][bj][m][0], v1 = acc[ai][bj][m][1];
                    u32x4 w; w.x = cvtpk(v0[0] * csv[bj][0], v0[1] * csv[bj][1]); w.y = cvtpk(v0[2] * csv[bj][2], v0[3] * csv[bj][3]);
                    w.z = cvtpk(v1[0] * csv[bj][4], v1[1] * csv[bj][5]); w.w = cvtpk(v1[2] * csv[bj][6], v1[3] * csv[bj][7]);
                    *(u32x4*)(rowp + bj * HALF) = w; } }
    }
};
struct EpiRetGate {
    static constexpr bool AFTER_DRAIN = false; static constexpr bool ROWSTAT = true;
    bf16_t* Y; long ldc; const float* rs; const float* gns; const float* gain;
    DI const float* statp() const { return rs; }   DI int stati(const Unit& u) const { return u.pm; }
    DI void operator()(const Acc& acc, const Unit& u, int wr, int wc, int fr, int fq, const LAS float* rt) const {
        const int row0 = u.pm * BM + wr * 64 + fr; const int col = u.pn * BM + wc * 32 + 8 * fq;
        float gv[2][8];
#pragma unroll
        for (int bj = 0; bj < 2; ++bj) { const f32x4 a = *(const f32x4*)(gain + col + bj * HALF), b = *(const f32x4*)(gain + col + bj * HALF + 4);
            gv[bj][0] = a[0]; gv[bj][1] = a[1]; gv[bj][2] = a[2]; gv[bj][3] = a[3]; gv[bj][4] = b[0]; gv[bj][5] = b[1]; gv[bj][6] = b[2]; gv[bj][7] = b[3]; }
        float pq[2]; f32x4 g0[2], g1[2]; u32x4 on[2][2];
#define RG_LOAD(slot, ai_, m_) do { const int row_ = row0 + (ai_) * HALF + (m_) * 16; pq[slot] = rstd_q(*(const LAS f32x4*)(rt + 4 * ((ai_) * HALF + wr * 64 + (m_) * 16 + fr))); \
            g0[slot] = *(const f32x4*)(gns + (size_t)row_ * 32 + (u.pn >> 1) * 8); g1[slot] = *(const f32x4*)(gns + (size_t)row_ * 32 + (u.pn >> 1) * 8 + 4); \
            on[slot][0] = *(const u32x4*)(Y + (size_t)row_ * ldc + col); on[slot][1] = *(const u32x4*)(Y + (size_t)row_ * ldc + col + HALF); } while (0)
        RG_LOAD(0, 0, 0);
#pragma unroll
        for (int ai = 0; ai < 2; ++ai)
#pragma unroll
            for (int m = 0; m < 4; ++m) { const int g = ai * 4 + m, sl = g & 1; const int row = row0 + ai * HALF + m * 16;
                if (g < 7) RG_LOAD(sl ^ 1, (g + 1) >> 2, (g + 1) & 3);
                asm volatile("" ::: "memory");
                const float r = pq[sl]; const f32x4 p0 = g0[sl], p1 = g1[sl];
                const float mu = ((p0[0] + p0[2]) + (p1[0] + p1[2])) * (1.0f / 512.0f), ex2v = ((p0[1] + p0[3]) + (p1[1] + p1[3])) * (1.0f / 512.0f);
                const float gr = __builtin_amdgcn_rsqf(fmaxf(ex2v - mu * mu, 0.f) + GN_EPS);
                bf16_t* rowp = Y + (size_t)row * ldc + col;
#pragma unroll
                for (int bj = 0; bj < 2; ++bj) { const u32x4 onv = on[sl][bj]; const f32x4 v0 = acc[ai][bj][m][0], v1 = acc[ai][bj][m][1];
                    u32x4 w;
                    w.x = cvtpk(silu(v0[0] * r) * (bflo(onv.x) - mu) * gr * gv[bj][0], silu(v0[1] * r) * (bfhi(onv.x) - mu) * gr * gv[bj][1]); w.y = cvtpk(silu(v0[2] * r) * (bflo(onv.y) - mu) * gr * gv[bj][2], silu(v0[3] * r) * (bfhi(onv.y) - mu) * gr * gv[bj][3]);
                    w.z = cvtpk(silu(v1[0] * r) * (bflo(onv.z) - mu) * gr * gv[bj][4], silu(v1[1] * r) * (bfhi(onv.z) - mu) * gr * gv[bj][5]); w.w = cvtpk(silu(v1[2] * r) * (bflo(onv.w) - mu) * gr * gv[bj][6], silu(v1[3] * r) * (bfhi(onv.w) - mu) * gr * gv[bj][7]);
                    *(u32x4*)(rowp + bj * HALF) = w; }
                asm volatile("" ::: "memory"); }
#undef RG_LOAD
    }
};
struct EpiNormRes {
    static constexpr bool AFTER_DRAIN = false; static constexpr bool ROWSTAT = false;
    const bf16_t* xin; bf16_t* xout; float* out32; float* ssq; const float* gpost; unsigned long long* xch; unsigned epoch; LAS unsigned char* tab;
    DI void operator()(Acc& acc, const Unit& u, int wr, int wc, int fr, int fq, const LAS float* rt) const {
        (void)rt;
        const int wid = wr * 4 + wc, lane = fq * 16 + fr;
        LAS float* P = (LAS float*)tab; LAS float* Sg = (LAS float*)(tab + 4096); LAS float* P2 = (LAS float*)(tab + 5120);
        const int col0 = u.pn * BM + wc * 32 + 8 * fq;
        u32x4 xp0[4][2], xp1[4][2];
#pragma unroll
        for (int m = 0; m < 4; ++m)
#pragma unroll
            for (int bj = 0; bj < 2; ++bj) xp0[m][bj] = *(const u32x4*)(xin + (size_t)(u.pm * BM + wr * 64 + m * 16 + fr) * DM + col0 + bj * HALF);
        float gv[2][8];
#pragma unroll
        for (int bj = 0; bj < 2; ++bj) { const f32x4 a = *(const f32x4*)(gpost + col0 + bj * HALF), b = *(const f32x4*)(gpost + col0 + bj * HALF + 4);
            gv[bj][0] = a[0]; gv[bj][1] = a[1]; gv[bj][2] = a[2]; gv[bj][3] = a[3]; gv[bj][4] = b[0]; gv[bj][5] = b[1]; gv[bj][6] = b[2]; gv[bj][7] = b[3]; }
        u32x2 pk[2][4][2];
#pragma unroll
        for (int ai = 1; ai >= 0; --ai) {
#pragma unroll
            for (int m = 0; m < 4; ++m) { float q = 0.f;
#pragma unroll
                for (int bj = 0; bj < 2; ++bj)
#pragma unroll
                    for (int n = 0; n < 2; ++n) { const f32x4 v = acc[ai][bj][m][n]; q += (v[0] * v[0] + v[1] * v[1]) + (v[2] * v[2] + v[3] * v[3]);
                        if (ai == 1) { pk[bj][m][n].x = cvtpk(v[0], v[1]); pk[bj][m][n].y = cvtpk(v[2], v[3]); } }
                q = xsum32(xsum16(q));
                if (fq == 0) P[(ai * HALF + wr * 64 + m * 16 + fr) * 4 + wc] = q; }
            if (ai == 1) { asm volatile("" ::: "memory");
#pragma unroll
                for (int m = 0; m < 4; ++m)
#pragma unroll
                    for (int bj = 0; bj < 2; ++bj) xp1[m][bj] = *(const u32x4*)(xin + (size_t)(u.pm * BM + HALF + wr * 64 + m * 16 + fr) * DM + col0 + bj * HALF);
                asm volatile("" ::: "memory"); }
        }
        LDS_WAIT(); __builtin_amdgcn_s_barrier(); asm volatile("" ::: "memory");
        const int row = wid * 32 + (lane & 31);
        if (lane < 32) { const f32x4 p = *(const LAS f32x4*)(P + row * 4); const float t = (p[0] + p[1]) + (p[2] + p[3]);
            unsigned long long* sl = xch + (size_t)(u.pm * BM + row) * 4;
            __hip_atomic_store(sl + u.pn, ((unsigned long long)epoch << 32) | __float_as_uint(t), __ATOMIC_RELAXED, __HIP_MEMORY_SCOPE_AGENT);
            float tot = 0.f; unsigned sp = 0;
            for (;;) { bool ok = true; tot = 0.f;
#pragma unroll
                for (int k = 0; k < 4; ++k) { const unsigned long long g = __hip_atomic_load(sl + k, __ATOMIC_RELAXED, __HIP_MEMORY_SCOPE_AGENT); ok &= ((unsigned)(g >> 32) == epoch); tot += __uint_as_float((unsigned)g); }
                if (ok || ++sp > (1u << 20)) break;
                __builtin_amdgcn_s_sleep(1); }
            Sg[row] = __builtin_amdgcn_rsqf(tot * (1.0f / DM) + RMS_EPS); }
        LDS_WAIT(); __builtin_amdgcn_s_barrier(); asm volatile("" ::: "memory");
        __builtin_amdgcn_s_waitcnt(0x0F70);
#pragma unroll
        for (int ai = 0; ai < 2; ++ai)
#pragma unroll
            for (int m = 0; m < 4; ++m) { const int r = ai * HALF + wr * 64 + m * 16 + fr; const float rm = Sg[r]; const size_t off = (size_t)(u.pm * BM + r) * DM + col0; float q = 0.f;
#pragma unroll
                for (int bj = 0; bj < 2; ++bj) { const u32x4 xv = ai ? xp1[m][bj] : xp0[m][bj];
                    f32x4 v0, v1;
                    if (ai == 0) { v0 = acc[0][bj][m][0]; v1 = acc[0][bj][m][1]; }
                    else { const u32x2 a = pk[bj][m][0], b = pk[bj][m][1]; v0 = (f32x4){bflo(a.x), bfhi(a.x), bflo(a.y), bfhi(a.y)}; v1 = (f32x4){bflo(b.x), bfhi(b.x), bflo(b.y), bfhi(b.y)}; }
                    float o[8];
                    o[0] = bflo(xv.x) + v0[0] * rm * gv[bj][0]; o[1] = bfhi(xv.x) + v0[1] * rm * gv[bj][1]; o[2] = bflo(xv.y) + v0[2] * rm * gv[bj][2]; o[3] = bfhi(xv.y) + v0[3] * rm * gv[bj][3];
                    o[4] = bflo(xv.z) + v1[0] * rm * gv[bj][4]; o[5] = bfhi(xv.z) + v1[1] * rm * gv[bj][5]; o[6] = bflo(xv.w) + v1[2] * rm * gv[bj][6]; o[7] = bfhi(xv.w) + v1[3] * rm * gv[bj][7];
                    u32x4 w; w.x = cvtpk(o[0], o[1]); w.y = cvtpk(o[2], o[3]); w.z = cvtpk(o[4], o[5]); w.w = cvtpk(o[6], o[7]);
                    *(u32x4*)(xout + off + bj * HALF) = w;
                    if (out32) { *(f32x4*)(out32 + off + bj * HALF) = (f32x4){o[0], o[1], o[2], o[3]}; *(f32x4*)(out32 + off + bj * HALF + 4) = (f32x4){o[4], o[5], o[6], o[7]}; }
                    const float r0 = bflo(w.x), r1 = bfhi(w.x), r2 = bflo(w.y), r3 = bfhi(w.y), r4 = bflo(w.z), r5 = bfhi(w.z), r6 = bflo(w.w), r7 = bfhi(w.w);
                    q += ((r0 * r0 + r1 * r1) + (r2 * r2 + r3 * r3)) + ((r4 * r4 + r5 * r5) + (r6 * r6 + r7 * r7)); }
                q = xsum32(xsum16(q));
                if (fq == 0) P2[r * 4 + wc] = q;
                asm volatile("" ::: "memory"); }
        LDS_WAIT(); __builtin_amdgcn_s_barrier(); asm volatile("" ::: "memory");
        if (lane < 32) { const f32x4 p = *(const LAS f32x4*)(P2 + row * 4); ssq[(size_t)(u.pm * BM + row) * 4 + u.pn] = (p[0] + p[1]) + (p[2] + p[3]); }
    }
};
}

#define XB_TMO      128
#define XB_XCNT(j)  (256  + 64 * (j))
#define XB_XSUB(j)  (1280 + 64 * (j))
#define XB_XGEN(j)  (2304 + 64 * (j))
#define XB_TOP      3328
#define XB_TOPGEN   3392
#define XCD_BAR_WORDS 3456
#define XB_SPIN_CAP (1u << 22)
DI unsigned xb_ld(unsigned* p)              { return __hip_atomic_load(p, __ATOMIC_RELAXED, __HIP_MEMORY_SCOPE_AGENT); }
DI unsigned xb_add(unsigned* p, unsigned v) { return __hip_atomic_fetch_add(p, v, __ATOMIC_RELAXED, __HIP_MEMORY_SCOPE_AGENT); }
DI unsigned xb_xcc_id() { return (unsigned)__builtin_amdgcn_s_getreg((3 << 11) | 20) & 0xFu; }
#define XB_SPIN(cond, bar) do { unsigned _sp = 0; while (cond) { __builtin_amdgcn_s_sleep(1); \
    if ((++_sp & 255u) == 0u) { if (xb_ld(&(bar)[XB_TMO])) break; if (_sp > XB_SPIN_CAP) { atomicAdd(&(bar)[XB_TMO], 1u); break; } } } } while (0)
struct XcdBarrier { unsigned* bar; unsigned x; volatile LAS unsigned* st; };
DI XcdBarrier xcd_barrier_post(unsigned* bar, volatile LAS unsigned* st) {
    XcdBarrier b; b.bar = bar; b.x = xb_xcc_id(); b.st = st;
    if (threadIdx.x == 0) (void)xb_add(&bar[XB_XCNT(b.x)], 1u);
    return b;
}
DI void xcd_barrier_complete(unsigned* bar, unsigned x, unsigned& nloc, unsigned& nx) {
    const unsigned G = gridDim.x * gridDim.y * gridDim.z;
    unsigned sum, cnt, mine, sp = 0u;
    for (;;) {
        sum = 0u; cnt = 0u; mine = 0u;
#pragma unroll
        for (unsigned j = 0; j < 16; ++j) { const unsigned c = xb_ld(&bar[XB_XCNT(j)]); sum += c; cnt += (c > 0u) ? 1u : 0u; mine = (j == x) ? c : mine; }
        if (sum == G) break;
        __builtin_amdgcn_s_sleep(1);
        if ((++sp & 255u) == 0u) { if (xb_ld(&bar[XB_TMO])) break; if (sp > XB_SPIN_CAP) { atomicAdd(&bar[XB_TMO], 1u); break; } }
    }
    nloc = mine > 0u ? mine : 1u; nx = cnt > 0u ? cnt : 1u;
}
DI void xcd_barrier(const XcdBarrier& b) {
    asm volatile("s_waitcnt vmcnt(0)" ::: "memory");
    __syncthreads();
    if (threadIdx.x == 0) {
        unsigned* bar = b.bar; asm volatile("" : "+s"(bar));
        __builtin_amdgcn_s_waitcnt(0);
        unsigned nloc = b.st[0], nx = b.st[1];
        if (nloc == 0u) { xcd_barrier_complete(bar, b.x, nloc, nx); b.st[0] = nloc; b.st[1] = nx; }
        const unsigned old = xb_add(&bar[XB_XSUB(b.x)], 1u);
        const unsigned gen = old / nloc;
        if (old + 1u == (gen + 1u) * nloc) {
            __builtin_amdgcn_fence(__ATOMIC_RELEASE, "agent");
            asm volatile("s_waitcnt vmcnt(0)" ::: "memory");
            const unsigned og = xb_add(&bar[XB_TOP], 1u);
            const unsigned tg = og / nx;
            if (og + 1u == (tg + 1u) * nx) xb_add(&bar[XB_TOPGEN], 1u);
            else XB_SPIN(xb_ld(&bar[XB_TOPGEN]) == tg, bar);
            __builtin_amdgcn_fence(__ATOMIC_ACQUIRE, "agent");
            xb_add(&bar[XB_XGEN(b.x)], 1u);
            asm volatile("s_waitcnt vmcnt(0)" ::: "memory");
        } else {
            XB_SPIN(xb_ld(&bar[XB_XGEN(b.x)]) == gen, bar);
            __builtin_amdgcn_fence(__ATOMIC_ACQUIRE, "agent");
            asm volatile("s_waitcnt vmcnt(0)" ::: "memory");
        }
    }
    __syncthreads();
}

DI void grp_barrier(unsigned* cnt, unsigned& gen, bool same_xcd) {
    asm volatile("s_waitcnt vmcnt(0)" ::: "memory");
    __syncthreads();
    if (threadIdx.x == 0) {
        __builtin_amdgcn_s_waitcnt(0);
        if (!same_xcd) { __builtin_amdgcn_fence(__ATOMIC_RELEASE, "agent"); asm volatile("s_waitcnt vmcnt(0)" ::: "memory"); }
        (void)xb_add(cnt, 1u);
        const unsigned target = 16u * (gen + 1u); unsigned sp = 0;
        while (xb_ld(cnt) < target) { __builtin_amdgcn_s_sleep(1); if (++sp > XB_SPIN_CAP) break; }
        __builtin_amdgcn_fence(__ATOMIC_ACQUIRE, "agent");
        asm volatile("s_waitcnt vmcnt(0)" ::: "memory");
    }
    ++gen;
    __syncthreads();
}

template <int RMAP> DI int rmap(int n) { return RMAP == 0 ? n : (RMAP == 1 ? (n >> 7) * 256 + (n & 127) : (RMAP == 2 ? (n >> 7) * 256 + 128 + (n & 127) : (n & ~31) + 8 * ((n >> 2) & 3) + 4 * ((n >> 4) & 1) + (n & 3))); }
template <int RMAP>
DI void cvt_weight(const float* W, int K, int ldw, int c0, int N, bf16_t* WT, int row_off, const float* gk, const float* gn, float scale, LAS float* scr_, int& rot, int NGW, int lane) {
    LAS bf16_t* scr = (LAS bf16_t*)scr_;
    const int nblk = N / 64, nitems = (K / 64) * nblk;
    const int first = rot; rot = (rot + NGW - nitems % NGW) % NGW;
    const int lr = lane >> 4, lc = (lane & 15) * 4;
    for (int item = first; item < nitems; item += NGW) {
        const int kb = item / nblk, nb = item % nblk, k0 = 64 * kb, n0 = 64 * nb;
        f32x4 gnv = {scale, scale, scale, scale};
        if (gn) { const f32x4 t = *(const f32x4*)(gn + n0 + lc); gnv = t * scale; }
        f32x4 v[16]; float gkq[16];
#pragma unroll
        for (int i = 0; i < 16; ++i) v[i] = *(const f32x4*)(W + (size_t)(k0 + 4 * i + lr) * ldw + c0 + n0 + lc);
#pragma unroll
        for (int i = 0; i < 16; ++i) gkq[i] = gk ? gk[k0 + 4 * i + lr] : 1.f;
        asm volatile("" ::: "memory");
#pragma unroll
        for (int i = 0; i < 16; ++i) { const int kk = 4 * i + lr; const float gkv = gkq[i]; const f32x4 o = v[i] * gnv * gkv;
            scr[(lc + 0) * 72 + kk] = (bf16_t)(cvtpk(o[0], 0.f) & 0xffffu); scr[(lc + 1) * 72 + kk] = (bf16_t)(cvtpk(o[1], 0.f) & 0xffffu);
            scr[(lc + 2) * 72 + kk] = (bf16_t)(cvtpk(o[2], 0.f) & 0xffffu); scr[(lc + 3) * 72 + kk] = (bf16_t)(cvtpk(o[3], 0.f) & 0xffffu); }
        LDS_WAIT(); asm volatile("" ::: "memory");
#pragma unroll
        for (int j = 0; j < 8; ++j) { const int n = 8 * j + (lane >> 3), c = lane & 7; const u32x4 o = *(const LAS u32x4*)(scr + n * 72 + 8 * c);
            *(u32x4*)(WT + (size_t)(row_off + rmap<RMAP>(n0 + n)) * K + k0 + 8 * c) = o; }
        LDS_WAIT(); asm volatile("" ::: "memory");
    }
}
DI void cvt_rows(const float* W, int K, bf16_t* dst, const float* gk, float scale, int& rot, int NGW, int lane) {
    const int first = rot; rot = (rot + NGW - K % NGW) % NGW;
    for (int k = first; k < K; k += NGW) { const float g = gk[k] * scale; const f32x4* xr = (const f32x4*)(W + (size_t)k * DM) + lane; u32x2* o8 = (u32x2*)(dst + (size_t)k * DM) + lane;
#pragma unroll
        for (int j = 0; j < 4; ++j) { const f32x4 v = xr[64 * j] * g; u32x2 w; w.x = cvtpk(v[0], v[1]); w.y = cvtpk(v[2], v[3]); o8[64 * j] = w; } }
}
DI void rows_to_bf16(const float* X, bf16_t* XB, float* RSTD, int nrows, float* Xcopy, int gw, int NGW, int lane) {
    asm volatile("" : "+v"(lane));
    (void)Xcopy;
    for (int row0 = 2 * gw; row0 < nrows; row0 += 2 * NGW) {
        f32x4 v[2][4]; float s[2];
#pragma unroll
        for (int k = 0; k < 2; ++k) { const f32x4* xr = (const f32x4*)(X + (size_t)(row0 + k) * DM) + lane;
#pragma unroll
            for (int j = 0; j < 4; ++j) v[k][j] = xr[64 * j]; }
#pragma unroll
        for (int k = 0; k < 2; ++k) { float q = 0.f;
#pragma unroll
            for (int j = 0; j < 4; ++j) q += (v[k][j][0] * v[k][j][0] + v[k][j][1] * v[k][j][1]) + (v[k][j][2] * v[k][j][2] + v[k][j][3] * v[k][j][3]);
            s[k] = wave_sum(q); }
#pragma unroll
        for (int k = 0; k < 2; ++k) {
            if (lane == 0) *(f32x4*)(RSTD + (size_t)(row0 + k) * 4) = (f32x4){s[k], 0.f, 0.f, 0.f};
            u32x2* o8 = (u32x2*)(XB + (size_t)(row0 + k) * DM) + lane;
#pragma unroll
            for (int j = 0; j < 4; ++j) { u32x2 w; w.x = cvtpk(v[k][j][0], v[k][j][1]); w.y = cvtpk(v[k][j][2], v[k][j][3]); o8[64 * j] = w; } }
    }
}
template <int W>
DI void pool_run(const bf16_t* X, bf16_t* DP, const f32x4 g, int r0, int tp0, int c, int rsA, int rsB) {
#define PP_RS(row_) (((row_) - (r0 - 16)) < 64 ? __int_as_float(__builtin_amdgcn_readlane(rsA, (row_) - (r0 - 16))) : __int_as_float(__builtin_amdgcn_readlane(rsB, (row_) - (r0 + 48))))
#define PP_F4(v_) ((f32x4){bflo((v_).x), bfhi((v_).x), bflo((v_).y), bfhi((v_).y)})
    const float invw = 1.0f / (float)W;
    u32x2 prev[16];
#pragma unroll
    for (int j = 0; j < 16; ++j) prev[j] = (u32x2){0u, 0u};
    f32x4 s = {0.f, 0.f, 0.f, 0.f};
#pragma unroll
    for (int j = 1; j < W; ++j) { if (tp0 - j >= 0) { const u32x2 xv = *(const u32x2*)(X + (size_t)(r0 - j) * DM + c); prev[16 - j] = xv; s += PP_F4(xv) * PP_RS(r0 - j) * g; } }
#pragma unroll 1
    for (int i0 = 0; i0 < 64; i0 += 8) {
        u32x2 xv[8];
#pragma unroll
        for (int k = 0; k < 8; ++k) xv[k] = *(const u32x2*)(X + (size_t)(r0 + i0 + k) * DM + c);
#pragma unroll
        for (int k = 0; k < 8; ++k) { const int row = r0 + i0 + k, tp = tp0 + i0 + k;
            const f32x4 h = PP_F4(xv[k]) * PP_RS(row) * g;
            s += h;
            const float inv = (tp + 1 < W) ? __builtin_amdgcn_rcpf((float)(tp + 1)) : invw;
            const f32x4 d = s * inv - h;
            u32x2 o; o.x = cvtpk(d[0], d[1]); o.y = cvtpk(d[2], d[3]);
            *(u32x2*)(DP + (size_t)row * DM + c) = o;
            if (tp - W + 1 >= 0) { constexpr int dummy_ = 0; (void)dummy_;
                const u32x2 xl = (k - W + 1 >= 0) ? xv[(k - W + 1 >= 0) ? (k - W + 1) : 0] : prev[(k - W + 1 < 0) ? (k - W + 1 + 16) : 0];
                s -= PP_F4(xl) * PP_RS(row - W + 1) * g; } }
        if (W > 1) {
#pragma unroll
            for (int j = 0; j < 8; ++j) prev[j] = prev[j + 8];
#pragma unroll
            for (int k = 0; k < 8; ++k) prev[8 + k] = xv[k]; }
    }
#undef PP_RS
#undef PP_F4
}
DI void pool_pre(const bf16_t* X, const float* SSQ, const float* gpre, bf16_t* DP, int run0, int run_end, int run_step, int tid) {
    asm volatile("" : "+v"(tid));
    const int lane = tid & 63;
    const int c = 4 * (tid & 255), w = __builtin_amdgcn_readfirstlane(2 << (c >> 8));
    const f32x4 g = *(const f32x4*)(gpre + c);
    for (int run = run0 + (tid >> 8) * run_step; run < run_end; run += 2 * run_step) {
        const int r0 = run * 64, tp0 = r0 & (SEQ - 1);
        const int ra = r0 - 16 + lane;
        const int rsA = __float_as_int(rstd_of(SSQ, ra < 0 ? 0 : ra)), rsB = __float_as_int(rstd_of(SSQ, r0 + 48 + (lane & 15)));
        if (w == 2) pool_run<2>(X, DP, g, r0, tp0, c, rsA, rsB);
        else if (w == 4) pool_run<4>(X, DP, g, r0, tp0, c, rsA, rsB);
        else if (w == 8) pool_run<8>(X, DP, g, r0, tp0, c, rsA, rsB);
        else pool_run<16>(X, DP, g, r0, tp0, c, rsA, rsB);
    }
}

#define MFMA32(a, b, c) __builtin_amdgcn_mfma_f32_32x32x16_bf16((a), (b), (c), 0, 0, 0)
#define MFMA16(a, b, c) __builtin_amdgcn_mfma_f32_16x16x32_bf16((a), (b), (c), 0, 0, 0)
#define SB_SUBTILE(Z, DIAG, ALLV, A, RUN) do { float sg_[16], kp_[16]; \
        _Pragma("unroll") for (int i = 0; i < 16; ++i) { const int ko = (i & 3) + 8 * (i >> 2) + 4 * hh; const bool valid = (ALLV) && (!(DIAG) || (ko < r)); \
              \
            const float zz = __builtin_amdgcn_fmed3f(Z[i], -126.0f, 126.0f), e = ex2(-zz), rc = __builtin_amdgcn_rcpf(1.0f + e), er = e * rc; \
            sg_[i] = valid ? rc : 0.f; kp_[i] = valid ? er : 1.f; } \
        float pg_[4], tg_[4];        \
        _Pragma("unroll") for (int g = 0; g < 4; ++g) { const float gp_ = (kp_[4 * g] * kp_[4 * g + 1]) * (kp_[4 * g + 2] * kp_[4 * g + 3]); \
            const auto sw_ = __builtin_amdgcn_permlane32_swap(__float_as_uint(gp_), __float_as_uint(gp_), false, false); const float r0_ = __uint_as_float(sw_[0]), r1_ = __uint_as_float(sw_[1]); \
            pg_[g] = r0_ * r1_; tg_[g] = hh ? 1.f : r1_; } \
        float run_ = 1.f, aft_[4]; \
        _Pragma("unroll") for (int g = 3; g >= 0; --g) { aft_[g] = run_ * tg_[g]; run_ *= pg_[g]; } \
        _Pragma("unroll") for (int g = 0; g < 4; ++g) { float c = aft_[g] * F; \
            _Pragma("unroll") for (int k = 3; k >= 0; --k) { A[4 * g + k] = sg_[4 * g + k] * c; c *= kp_[4 * g + k]; } } \
        RUN = run_; } while (0)
DI void sb_attention(const bf16_t* QK, const bf16_t* VT, bf16_t* O, LAS unsigned char* lds, int vcu, int G, int tid_in) {
    int tid = tid_in; asm volatile("" : "+v"(tid));
    const int lane = tid & 63, wave = __builtin_amdgcn_readfirstlane(tid >> 6), r = lane & 31, hh = lane >> 5;
    for (int bh = vcu; bh < NB * 16; bh += G) {
        const int h = bh & 15, b = bh >> 4;
        const bf16_t* kbase = QK + (size_t)(b * SEQ + r) * 2048 + 1024 + h * 64 + 8 * hh;
        const bf16_t* vbase = VT + ((size_t)b * 1024 + h * 64 + r) * LDT + 4 * hh;
        unsigned koff[4], voff[4];
#pragma unroll
        for (int q = 0; q < 4; ++q) { const int sl = (wave * 4 + q) * 64 + lane;
            { const int row = sl >> 3, piece = (sl & 7) ^ (row & 7); koff[q] = (unsigned)(row * 2048 + piece * 8); }
            { const int d = sl >> 5, sp = sl & 31; voff[q] = (unsigned)(d * LDT + (sp ^ (d & 15)) * 8); } }
        u32x4 kp[8]; bf16x8 qf[4];
#define SB_FETCH(U_) do { const int T0n_ = (U_) * 256; const bf16_t* ksrc_ = QK + (size_t)(b * SEQ + T0n_) * 2048 + 1024 + h * 64; const bf16_t* vsrc_ = VT + ((size_t)b * 1024 + h * 64) * LDT + T0n_; \
            _Pragma("unroll") for (int q = 0; q < 4; ++q) { kp[q] = *(const u32x4*)(ksrc_ + koff[q]); kp[4 + q] = *(const u32x4*)(vsrc_ + voff[q]); } \
            } while (0)
#define SB_QLOAD(U_) do { const bf16_t* qpn_ = QK + (size_t)(b * SEQ + (U_) * 256 + wave * 32 + r) * 2048 + h * 64 + 8 * hh; \
            _Pragma("unroll") for (int s_ = 0; s_ < 4; ++s_) qf[s_] = *(const bf16x8*)(qpn_ + 16 * s_); } while (0)
#define SB_FILL(U_) do { const int hn_ = (U_) & 1; _Pragma("unroll") for (int q = 0; q < 4; ++q) { \
            *(LAS u32x4*)(lds + hn_ * 32768 + (wave * 4 + q) * 1024 + lane * 16) = kp[q]; *(LAS u32x4*)(lds + 65536 + hn_ * 32768 + (wave * 4 + q) * 1024 + lane * 16) = kp[4 + q]; } } while (0)
        SB_FETCH(0); SB_QLOAD(0);
        __builtin_amdgcn_s_waitcnt(0x0F70);
        SB_FILL(0);
        SB_FETCH(1);
        asm volatile("s_waitcnt lgkmcnt(0)" ::: "memory"); __builtin_amdgcn_s_barrier(); asm volatile("" ::: "memory");
#pragma unroll 1
        for (int unit = 0; unit < SEQ / 256; ++unit) {
            const int T0 = unit * 256, t0 = T0 + wave * 32;
            const int ring_lo = T0 >= 256 ? T0 - 256 : 0;
            f32x16 o0, o1;
#pragma unroll
            for (int i = 0; i < 16; ++i) { o0[i] = 0.f; o1[i] = 0.f; }
            float F = 1.f, R = 0.f;
            int sb = t0 - 32;
            for (;;) {
                const bool lval = sb >= 0; const int sbl = lval ? sb : 0, sbh = sb + 32;
                bf16x8 kH[4], kL[4]; bf16x4 vH[2][2][2], vL[2][2][2];
                const bool ring = sbl >= ring_lo;
                if (ring) {
                    const int rh = (sbh + r) & 511, rl = (sbl + r) & 511;
#pragma unroll
                    for (int s = 0; s < 4; ++s) { kH[s] = *(const LAS bf16x8*)(lds + rh * 128 + (((2 * s + hh) ^ (rh & 7)) << 4)); kL[s] = *(const LAS bf16x8*)(lds + rl * 128 + (((2 * s + hh) ^ (rl & 7)) << 4)); }
                } else {
#pragma unroll
                    for (int s = 0; s < 4; ++s) { kH[s] = *(const bf16x8*)(kbase + (size_t)sbh * 2048 + 16 * s); kL[s] = *(const bf16x8*)(kbase + (size_t)sbl * 2048 + 16 * s); }
#pragma unroll
                    for (int dt = 0; dt < 2; ++dt)
#pragma unroll
                        for (int s = 0; s < 2; ++s)
#pragma unroll
                            for (int p = 0; p < 2; ++p) { vH[dt][s][p] = *(const bf16x4*)(vbase + (size_t)dt * 32 * LDT + sbh + 16 * s + 8 * p); vL[dt][s][p] = *(const bf16x4*)(vbase + (size_t)dt * 32 * LDT + sbl + 16 * s + 8 * p); }
                    __builtin_amdgcn_s_waitcnt(0x0F70);
                }
                const int nsb = sb - 64; const bool more = nsb >= -32;
                f32x16 zH, zL;
#pragma unroll
                for (int i = 0; i < 16; ++i) { zH[i] = 0.f; zL[i] = 0.f; }
#pragma unroll
                for (int s = 0; s < 4; ++s) { zH = MFMA32(kH[s], qf[s], zH); zL = MFMA32(kL[s], qf[s], zL); }
                if (ring) {
#pragma unroll
                    for (int dt = 0; dt < 2; ++dt)
#pragma unroll
                        for (int s = 0; s < 2; ++s)
#pragma unroll
                            for (int p = 0; p < 2; ++p) { const int d = 32 * dt + r; const int ph = ((sbh & 255) >> 3) + 2 * s + p, pl = ((sbl & 255) >> 3) + 2 * s + p;
                                vH[dt][s][p] = *(const LAS bf16x4*)(lds + 65536 + ((sbh >> 8) & 1) * 32768 + d * 512 + ((ph ^ (d & 15)) << 4) + hh * 8);
                                vL[dt][s][p] = *(const LAS bf16x4*)(lds + 65536 + ((sbl >> 8) & 1) * 32768 + d * 512 + ((pl ^ (d & 15)) << 4) + hh * 8); }
                }
                float aH[16], aL[16], runH, runL;
                if (sbh == t0) SB_SUBTILE(zH, true, true, aH, runH); else SB_SUBTILE(zH, false, true, aH, runH);
                F *= runH;
#pragma unroll
                for (int s = 0; s < 2; ++s) {
                    u32x4 w; w.x = cvtpk(aH[8 * s + 0], aH[8 * s + 1]); w.y = cvtpk(aH[8 * s + 2], aH[8 * s + 3]); w.z = cvtpk(aH[8 * s + 4], aH[8 * s + 5]); w.w = cvtpk(aH[8 * s + 6], aH[8 * s + 7]);
                    const bf16x8 pH = __builtin_bit_cast(bf16x8, w);
                    o0 = MFMA32(__builtin_shufflevector(vH[0][s][0], vH[0][s][1], 0, 1, 2, 3, 4, 5, 6, 7), pH, o0); o1 = MFMA32(__builtin_shufflevector(vH[1][s][0], vH[1][s][1], 0, 1, 2, 3, 4, 5, 6, 7), pH, o1); }
                if (lval) SB_SUBTILE(zL, false, true, aL, runL);
                else {
#pragma unroll
                    for (int i = 0; i < 16; ++i) aL[i] = 0.f;
                    runL = 1.f; }
                F *= runL;
                R -= lg2(runH) + lg2(runL);
#pragma unroll
                for (int s = 0; s < 2; ++s) {
                    u32x4 w; w.x = cvtpk(aL[8 * s + 0], aL[8 * s + 1]); w.y = cvtpk(aL[8 * s + 2], aL[8 * s + 3]); w.z = cvtpk(aL[8 * s + 4], aL[8 * s + 5]); w.w = cvtpk(aL[8 * s + 6], aL[8 * s + 7]);
                    const bf16x8 pL = __builtin_bit_cast(bf16x8, w);
                    o0 = MFMA32(__builtin_shufflevector(vL[0][s][0], vL[0][s][1], 0, 1, 2, 3, 4, 5, 6, 7), pL, o0); o1 = MFMA32(__builtin_shufflevector(vL[1][s][0], vL[1][s][1], 0, 1, 2, 3, 4, 5, 6, 7), pL, o1); }
                if (!more) break;
                if (__all(R >= 151.0f)) break;
                sb = nsb;
            }
            bf16_t* op = O + (size_t)(b * SEQ + t0 + r) * DM + h * 64 + 4 * hh;
#pragma unroll
            for (int g = 0; g < 4; ++g) {
                u32x2 w; w.x = cvtpk(o0[4 * g], o0[4 * g + 1]); w.y = cvtpk(o0[4 * g + 2], o0[4 * g + 3]); *(u32x2*)(op + 8 * g) = w;
                w.x = cvtpk(o1[4 * g], o1[4 * g + 1]); w.y = cvtpk(o1[4 * g + 2], o1[4 * g + 3]); *(u32x2*)(op + 32 + 8 * g) = w; }
            if (unit + 1 < SEQ / 256) {
                SB_QLOAD(unit + 1);
                asm volatile("s_waitcnt lgkmcnt(0)" ::: "memory"); __builtin_amdgcn_s_barrier(); asm volatile("" ::: "memory");
                __builtin_amdgcn_s_waitcnt(0x0F7C);
                SB_FILL(unit + 1);
                if (unit + 2 < SEQ / 256) SB_FETCH(unit + 2);
                asm volatile("s_waitcnt lgkmcnt(0)" ::: "memory"); __builtin_amdgcn_s_barrier(); asm volatile("" ::: "memory");
            }
        }
#undef SB_FETCH
#undef SB_QLOAD
#undef SB_FILL
        asm volatile("s_waitcnt lgkmcnt(0)" ::: "memory"); __builtin_amdgcn_s_barrier(); asm volatile("" ::: "memory");
    }
}

DI void ret_scores(const bf16_t* QKn, bf16_t* SC, int u0, int u_end, int u_step, int lane) {
    asm volatile("" : "+v"(lane));
    const int fr = lane & 15, fq = lane >> 4;
    for (int u = u0; u < u_end; u += u_step) {
        const int c = u & 63, h = (u >> 6) & 3, bl = u >> 8;
        const bf16_t* qb = QKn + (size_t)(bl * SEQ + c * 64) * 2048 + h * 256 + 8 * fq;
        const bf16_t* kbp = qb + 1024;
        bf16_t* sc = SC + (size_t)u * 4096;
        bf16x8 kf[4][8];
#pragma unroll
        for (int mt = 0; mt < 4; ++mt)
#pragma unroll
            for (int ks = 0; ks < 8; ++ks) kf[mt][ks] = *(const bf16x8*)(kbp + (size_t)(16 * mt + fr) * 2048 + 32 * ks);
        if (fr & 8) {
#pragma unroll
            for (int mt = 0; mt < 4; ++mt)
#pragma unroll
                for (int ks = 0; ks < 8; ++ks) kf[mt][ks] = __builtin_shufflevector(kf[mt][ks], kf[mt][ks], 4, 5, 6, 7, 0, 1, 2, 3); }
        bf16x8 qf[2][8];
#pragma unroll
        for (int ks = 0; ks < 8; ++ks) qf[0][ks] = *(const bf16x8*)(qb + (size_t)fr * 2048 + 32 * ks);
#pragma unroll
        for (int nt = 0; nt < 4; ++nt) {
            if (nt < 3) {
#pragma unroll
                for (int ks = 0; ks < 8; ++ks) qf[(nt + 1) & 1][ks] = *(const bf16x8*)(qb + (size_t)(16 * (nt + 1) + fr) * 2048 + 32 * ks); }
#pragma unroll
            for (int mt = 0; mt < 4; ++mt) {
                f32x4 acc = {0.f, 0.f, 0.f, 0.f};
                if (mt <= nt) {
#pragma unroll
                    for (int ks = 0; ks < 8; ++ks) acc = MFMA16(kf[mt][ks], qf[nt & 1][ks], acc);
                    const int n = 16 * nt + fr;
#pragma unroll
                    for (int i = 0; i < 4; ++i) { const int m = 16 * mt + 4 * fq + i; acc[i] = (n >= m) ? acc[i] : 0.f; }
                }
                u32x2 w; w.x = cvtpk(acc[0], acc[1]); w.y = cvtpk(acc[2], acc[3]);
                *(u32x2*)(sc + (16 * nt + fr) * 64 + 16 * mt + 4 * fq) = w;
            }
        }
    }
}
DI void ret_scan(const bf16_t* QKn, const bf16_t* KVT, const bf16_t* SC, bf16_t* O, float* gns, LAS unsigned char* lds, int vcu, int G, int tid_in) {
    int tid = tid_in; asm volatile("" : "+v"(tid));
    const int lane = tid & 63, wave = __builtin_amdgcn_readfirstlane(tid >> 6), fr = lane & 15, fq = lane >> 4;
    LAS unsigned char* OUT = lds + SMX_OFF;
    constexpr int OUTP = 272;
    for (int task = vcu; task < NB * 16; task += G) {
        const int eb = task & 3, h = (task >> 2) & 3, bl = task >> 4, e0 = eb * 128 + wave * 16;
        const float g64 = ex2(64.0f * lg2(1.0f - ex2(-5.0f - (float)h)));
        const bf16_t* qsrc = QKn + (size_t)(bl * SEQ) * 2048 + h * 256;
        const bf16_t* vtp = KVT + (size_t)bl * 2048 * LDR + (size_t)(h * 512 + e0 + fr) * LDR + 8 * fq;
        const bf16_t* scp = SC + (size_t)((bl * 4 + h) * 64) * 4096 + fr * 64 + 8 * fq;
        bf16_t* ob = O + (size_t)(bl * SEQ) * 2048 + h * 512 + eb * 128;
#define RS_DMA(c_, buf_) do { int ln_ = lane; asm volatile("" : "+v"(ln_)); _Pragma("unroll") for (int q = 0; q < 4; ++q) { const int sl = (wave * 4 + q) * 64 + ln_, row = sl >> 5; \
            const unsigned qo = (unsigned)(row * 2048 + (((sl & 31) ^ (row & 15)) << 3)), ko = (unsigned)(row * 2048 + (((sl & 31) ^ ((row & 3) << 2)) << 3)) + 1024u;     \
            __builtin_amdgcn_global_load_lds((const unsigned*)(qsrc + (size_t)(c_) * 64 * 2048 + qo), (LAS unsigned*)(lds + (buf_) * 65536 + (wave * 4 + q) * 1024), 16, 0, 0); \
            __builtin_amdgcn_global_load_lds((const unsigned*)(qsrc + (size_t)(c_) * 64 * 2048 + ko), (LAS unsigned*)(lds + (buf_) * 65536 + 32768 + (wave * 4 + q) * 1024), 16, 0, 0); } } while (0)
#define RS_DMA1(c_, buf_, P_) do { int ln_ = lane; asm volatile("" : "+v"(ln_)); const int q_ = (P_) >> 1; const int sl = (wave * 4 + q_) * 64 + ln_, row = sl >> 5; \
            if (((P_) & 1) == 0) { const unsigned qo = (unsigned)(row * 2048 + (((sl & 31) ^ (row & 15)) << 3)); \
                __builtin_amdgcn_global_load_lds((const unsigned*)(qsrc + (size_t)(c_) * 64 * 2048 + qo), (LAS unsigned*)(lds + (buf_) * 65536 + (wave * 4 + q_) * 1024), 16, 0, 0); } \
            else { const unsigned ko = (unsigned)(row * 2048 + (((sl & 31) ^ ((row & 3) << 2)) << 3)) + 1024u; \
                __builtin_amdgcn_global_load_lds((const unsigned*)(qsrc + (size_t)(c_) * 64 * 2048 + ko), (LAS unsigned*)(lds + (buf_) * 65536 + 32768 + (wave * 4 + q_) * 1024), 16, 0, 0); } } while (0)
#define RS_STORE_OUT(c_) do { _Pragma("unroll") for (int q = 0; q < 2; ++q) { const int idx = tid + 512 * q, p = idx >> 4, pc = idx & 15; \
            const u32x4 v = *(const LAS u32x4*)(OUT + p * OUTP + pc * 16); *(u32x4*)(ob + (size_t)(p * 64 + (c_)) * 2048 + pc * 8) = v; \
            const float a0 = bflo(v.x), a1 = bfhi(v.x), a2 = bflo(v.y), a3 = bfhi(v.y), a4 = bflo(v.z), a5 = bfhi(v.z), a6 = bflo(v.w), a7 = bfhi(v.w); \
            float s1 = ((a0 + a1) + (a2 + a3)) + ((a4 + a5) + (a6 + a7)), s2 = ((a0 * a0 + a1 * a1) + (a2 * a2 + a3 * a3)) + ((a4 * a4 + a5 * a5) + (a6 * a6 + a7 * a7)); \
            s1 = rowsum16(s1); s2 = rowsum16(s2); \
            if (pc == 0) *(f32x2*)(gns + (size_t)(bl * SEQ + p * 64 + (c_)) * 32 + h * 8 + eb * 2) = (f32x2){s1, s2}; } } while (0)
        f32x4 S[16];
#pragma unroll
        for (int T = 0; T < 16; ++T) S[T] = (f32x4){0.f, 0.f, 0.f, 0.f};
        bf16x8 scr[8], vcur[2], vnext[2];
        RS_DMA(0, 0);
#pragma unroll
        for (int k2 = 0; k2 < 2; ++k2) { vcur[k2] = *(const bf16x8*)(vtp + 32 * k2); vnext[k2] = vcur[k2]; }
#pragma unroll
        for (int k2 = 0; k2 < 2; ++k2)
#pragma unroll
            for (int nt = 0; nt < 4; ++nt) scr[k2 * 4 + nt] = *(const bf16x8*)(scp + (16 * nt) * 64 + 32 * k2);
#pragma unroll 1
        for (int c = 0; c < 64; ++c) {
            asm volatile("s_waitcnt vmcnt(0) lgkmcnt(0)" ::: "memory"); __builtin_amdgcn_s_barrier(); asm volatile("" ::: "memory");
            const int buf = c & 1;
            const bool pre = c + 1 < 64;
            if (pre) {
#pragma unroll
                for (int k2 = 0; k2 < 2; ++k2) vnext[k2] = *(const bf16x8*)(vtp + (c + 1) * 64 + 32 * k2); }
            if (c > 0) RS_STORE_OUT(c - 1);
            const LAS unsigned char* Qb = lds + buf * 65536; LAS unsigned char* Kb = lds + buf * 65536 + 32768;
            int q4 = fr >> 2; asm volatile("" : "+v"(q4));
            LAS unsigned char* krow = Kb + (8 * fq + q4) * 512 + (fr & 3) * 16;
            f32x4 acc[4];
#pragma unroll
            for (int nt = 0; nt < 4; ++nt) acc[nt] = (f32x4){0.f, 0.f, 0.f, 0.f};
            bf16x8 aQ[3][4];
#define RS_QREAD(bufi, KS) do { const unsigned qa_ = (unsigned)(size_t)(Qb + fr * 512 + (((4 * (KS) + fq) ^ fr) << 4)); \
                asm volatile("ds_read_b128 %0, %1" : "=v"(aQ[bufi][0]) : "v"(qa_)); asm volatile("ds_read_b128 %0, %1 offset:8192" : "=v"(aQ[bufi][1]) : "v"(qa_)); \
                asm volatile("ds_read_b128 %0, %1 offset:16384" : "=v"(aQ[bufi][2]) : "v"(qa_)); asm volatile("ds_read_b128 %0, %1 offset:24576" : "=v"(aQ[bufi][3]) : "v"(qa_)); } while (0)
#define RS_QWAIT(bufi, N) asm volatile("s_waitcnt lgkmcnt(" #N ")" : "+v"(aQ[bufi][0]), "+v"(aQ[bufi][1]), "+v"(aQ[bufi][2]), "+v"(aQ[bufi][3]))
            RS_QREAD(0, 0); RS_QREAD(1, 1);
#pragma unroll
            for (int ks = 0; ks < 8; ++ks) {
                if (pre) RS_DMA1(c + 1, buf ^ 1, ks);
                if (ks < 6) { RS_QREAD((ks + 2) % 3, ks + 2); RS_QWAIT(ks % 3, 8); }
                else if (ks == 6) RS_QWAIT(ks % 3, 4);
                else RS_QWAIT(ks % 3, 0);
                u32x4 w; w.x = cvtpk(S[2 * ks][0], S[2 * ks][1]); w.y = cvtpk(S[2 * ks][2], S[2 * ks][3]); w.z = cvtpk(S[2 * ks + 1][0], S[2 * ks + 1][1]); w.w = cvtpk(S[2 * ks + 1][2], S[2 * ks + 1][3]);
                const bf16x8 bS = __builtin_bit_cast(bf16x8, w);
#pragma unroll
                for (int nt = 0; nt < 4; ++nt) acc[nt] = MFMA16(bS, aQ[ks % 3][nt], acc[nt]);
            }
#undef RS_QREAD
#undef RS_QWAIT
#pragma unroll
            for (int nt = 0; nt < 4; ++nt) acc[nt] *= g64;
#pragma unroll
            for (int k2 = 0; k2 < 2; ++k2)
#pragma unroll
                for (int nt = 0; nt < 4; ++nt) acc[nt] = MFMA16(vcur[k2], scr[k2 * 4 + nt], acc[nt]);
            if (c + 1 < 64) {
#pragma unroll
                for (int k2 = 0; k2 < 2; ++k2)
#pragma unroll
                    for (int nt = 0; nt < 4; ++nt) scr[k2 * 4 + nt] = *(const bf16x8*)(scp + (size_t)(c + 1) * 4096 + (16 * nt) * 64 + 32 * k2); }
            asm volatile("s_waitcnt lgkmcnt(0)" ::: "memory"); __builtin_amdgcn_s_barrier(); asm volatile("" ::: "memory");
#pragma unroll
            for (int nt = 0; nt < 4; ++nt) { u32x2 w; w.x = cvtpk(acc[nt][0], acc[nt][1]); w.y = cvtpk(acc[nt][2], acc[nt][3]);
                *(LAS u32x2*)(OUT + (16 * nt + fr) * OUTP + wave * 32 + fq * 8) = w; }
            const int hsw8 = (fq & 1) * 8;
            bf16x4 kf[4][4];
#define RS_KREAD(bufi, TT) do { const unsigned ka_ = (unsigned)(size_t)(krow + (((((TT) >> 1) ^ q4) << 6) + ((((TT) & 1) * 8) ^ hsw8))); \
                asm volatile("ds_read_b64_tr_b16 %0, %1" : "=v"(kf[bufi][0]) : "v"(ka_)); asm volatile("ds_read_b64_tr_b16 %0, %1 offset:2048" : "=v"(kf[bufi][1]) : "v"(ka_)); \
                asm volatile("ds_read_b64_tr_b16 %0, %1 offset:16384" : "=v"(kf[bufi][2]) : "v"(ka_)); asm volatile("ds_read_b64_tr_b16 %0, %1 offset:18432" : "=v"(kf[bufi][3]) : "v"(ka_)); } while (0)
#define RS_KWAIT(bufi, N) asm volatile("s_waitcnt lgkmcnt(" #N ")" : "+v"(kf[bufi][0]), "+v"(kf[bufi][1]), "+v"(kf[bufi][2]), "+v"(kf[bufi][3]))
            RS_KREAD(0, 0); RS_KREAD(1, 1); RS_KREAD(2, 2);
#pragma unroll
            for (int T = 0; T < 16; ++T) {
                if (T < 13) { RS_KREAD((T + 3) & 3, T + 3); RS_KWAIT(T & 3, 12); }
                else if (T == 13) RS_KWAIT(T & 3, 8);
                else if (T == 14) RS_KWAIT(T & 3, 4);
                else RS_KWAIT(T & 3, 0);
                f32x4 sv = S[T] * g64;
#pragma unroll
                for (int k2 = 0; k2 < 2; ++k2) { const bf16x8 aK = __builtin_shufflevector(kf[T & 3][2 * k2], kf[T & 3][2 * k2 + 1], 0, 1, 2, 3, 4, 5, 6, 7); sv = MFMA16(aK, vcur[k2], sv); }
                S[T] = sv;
            }
#undef RS_KWAIT
#undef RS_KREAD
            vcur[0] = vnext[0]; vcur[1] = vnext[1];
        }
        asm volatile("s_waitcnt vmcnt(0) lgkmcnt(0)" ::: "memory"); __builtin_amdgcn_s_barrier(); asm volatile("" ::: "memory");
        RS_STORE_OUT(63);
        asm volatile("s_waitcnt lgkmcnt(0)" ::: "memory"); __builtin_amdgcn_s_barrier(); asm volatile("" ::: "memory");
#undef RS_DMA
#undef RS_STORE_OUT
    }
}
DI GAS unsigned char* opq(unsigned char* p) { GAS unsigned char* q = (GAS unsigned char*)p; asm volatile("" : "+s"(q)); return q; }
struct Args { const float* in[21]; float* out; unsigned char* ws; };
static_assert(sizeof(Args) == 23 * 8, "no padding");

__global__ void __launch_bounds__(512, 2) fwd_kernel(Args args) {
    extern __shared__ __attribute__((aligned(16))) unsigned char lds_raw[];
    LAS unsigned char* lds = (LAS unsigned char*)lds_raw;
    volatile LAS unsigned* MISC = (volatile LAS unsigned*)(lds + MISC_OFF);
    const int tid = threadIdx.x, lane = tid & 63, wave = __builtin_amdgcn_readfirstlane(tid >> 6);
    const int G = gridDim.x, bx = blockIdx.x, vcu = (G % 8 == 0) ? (bx % 8) * (G / 8) + bx / 8 : bx;
    const int gw = vcu * 8 + wave, NGW = G * 8;
    const int grp = vcu >> 4, wg16 = vcu & 15;
    unsigned char* ws = args.ws;
    unsigned* ctl = (unsigned*)(ws + WS_CTL);
    for (int u = tid; u < 64; u += 512) ((LAS unsigned*)(lds + MISC_OFF))[u] = 0u;
    __syncthreads();
    XcdBarrier bar = xcd_barrier_post(ctl + CW_BAR, MISC + 8);
#define GRID_BAR() xcd_barrier(bar)
    if (tid == 0) (void)__hip_atomic_fetch_or(ctl + CW_GRP + 64 * (16 + (vcu >> 4)), 1u << xb_xcc_id(), __ATOMIC_RELAXED, __HIP_MEMORY_SCOPE_AGENT);

    const float* x_in = args.in[0]; const float* mem = args.in[1];
    const float* n_mix_pre = args.in[2]; const float* n_mix_post = args.in[3]; const float* n_xa_pre = args.in[4]; const float* n_xa_post = args.in[5];
    const float* n_mem = args.in[6]; const float* n_ffn_pre = args.in[7]; const float* n_ffn_post = args.in[8];
    const float* pool_w = args.in[9]; const float* pool_scale = args.in[10]; const float* sb_w_in = args.in[11]; const float* sb_w_out = args.in[12];
    const float* ret_w_in = args.in[13]; const float* ret_gn = args.in[14]; const float* ret_w_out = args.in[15];
    const float* xa_w_q = args.in[16]; const float* xa_w_kv = args.in[17]; const float* xa_w_o = args.in[18]; const float* ffn_w_in = args.in[19]; const float* ffn_w_out = args.in[20];
    float* X = args.out;
#define RSTD  ((float*)(GAS float*)(opq(ws) + WS_SSQ))
#define MRSTD ((float*)(GAS float*)(opq(ws) + WS_MRSTD))
#define ropeK ((float*)(GAS float*)(opq(ws) + WS_ROPE))
#define MEMB  ((bf16_t*)(GAS bf16_t*)(opq(ws) + WS_MEMB))
#define KMEM  ((bf16_t*)(GAS bf16_t*)(opq(ws) + WS_KMEM))
#define VTMEM ((bf16_t*)(GAS bf16_t*)(opq(ws) + WS_VTMEM))
#define WB    ((bf16_t*)(GAS bf16_t*)(opq(ws) + WS_WB))
#define XB    ((bf16_t*)(GAS bf16_t*)(opq(ws) + WS_XB))
#define R     ((unsigned char*)(opq(ws) + WS_R))

    {
        LAS float* scr = (LAS float*)(lds + wave * 16384); int rot = gw;
        for (int j = 0; j < 2; ++j) {
            for (int g = 0; g < 4; ++g)
                cvt_weight<0>(pool_w + (size_t)(j * 4 + g) * 65536, 256, 256, 0, 256, WB + WO_POOL + (size_t)(j * 4 + g) * 65536, 0, nullptr, pool_scale + j * DM + g * 256, 1.f, scr, rot, NGW, lane);
        }
        cvt_weight<0>(sb_w_in, 1024, 3072, 0, 1024, WB + WO_SB_QK, 0, n_mix_pre + 1 * DM, nullptr, 0.125f * LOG2E, scr, rot, NGW, lane);
        cvt_weight<0>(sb_w_in, 1024, 3072, 1024, 1024, WB + WO_SB_QK, 1024, n_mix_pre + 1 * DM, nullptr, 1.f, scr, rot, NGW, lane);
        cvt_weight<0>(sb_w_in, 1024, 3072, 2048, 1024, WB + WO_SB_V, 0, n_mix_pre + 1 * DM, nullptr, 1.f, scr, rot, NGW, lane);
        cvt_weight<0>(sb_w_out, 1024, 1024, 0, 1024, WB + WO_SB_O, 0, nullptr, nullptr, 1.f, scr, rot, NGW, lane);
        cvt_weight<3>(ret_w_in, 1024, 6144, 0, 1024, WB + WO_RT_QK, 0, n_mix_pre + 2 * DM, nullptr, 1.f, scr, rot, NGW, lane);
        cvt_weight<3>(ret_w_in, 1024, 6144, 1024, 1024, WB + WO_RT_QK, 1024, n_mix_pre + 2 * DM, nullptr, 0.0625f, scr, rot, NGW, lane);
        cvt_weight<0>(ret_w_in, 1024, 6144, 2048, 2048, WB + WO_RT_KV, 0, n_mix_pre + 2 * DM, nullptr, 1.f, scr, rot, NGW, lane);
        cvt_weight<0>(ret_w_in, 1024, 6144, 4096, 2048, WB + WO_RT_G, 0, n_mix_pre + 2 * DM, nullptr, 1.f, scr, rot, NGW, lane);
        cvt_weight<0>(ret_w_out, 2048, 1024, 0, 1024, WB + WO_RT_O, 0, nullptr, nullptr, 1.f, scr, rot, NGW, lane);
        for (int i = 0; i < DEPTH; ++i) {
            cvt_rows(xa_w_q + (size_t)i * 1048576, 1024, WB + WO_XA_Q + (size_t)i * 1048576, n_xa_pre + i * DM, 0.0625f * LOG2E, rot, NGW, lane);
            cvt_weight<0>(xa_w_kv + (size_t)i * 2097152, 1024, 2048, 0, 1024, WB + WO_XA_K + (size_t)i * 1048576, 0, n_mem + i * DM, nullptr, 1.f, scr, rot, NGW, lane);
            cvt_weight<0>(xa_w_kv + (size_t)i * 2097152, 1024, 2048, 1024, 1024, WB + WO_XA_V + (size_t)i * 1048576, 0, n_mem + i * DM, nullptr, 1.f, scr, rot, NGW, lane);
            cvt_weight<0>(xa_w_o + (size_t)i * 1048576, 1024, 1024, 0, 1024, WB + WO_XA_O + (size_t)i * 1048576, 0, nullptr, nullptr, 1.f, scr, rot, NGW, lane);
            cvt_weight<1>(ffn_w_in + (size_t)i * 1024 * 5632, 1024, 5632, 0, 2816, WB + WO_FF_IN + (size_t)i * 5632 * 1024, 0, n_ffn_pre + i * DM, nullptr, 1.f, scr, rot, NGW, lane);
            cvt_weight<2>(ffn_w_in + (size_t)i * 1024 * 5632, 1024, 5632, 2816, 2816, WB + WO_FF_IN + (size_t)i * 5632 * 1024, 0, n_ffn_pre + i * DM, nullptr, 1.f, scr, rot, NGW, lane);
            cvt_weight<0>(ffn_w_out + (size_t)i * 2816 * 1024, 2816, 1024, 0, 1024, WB + WO_FF_OUT + (size_t)i * 1024 * 2816, 0, nullptr, nullptr, 1.f, scr, rot, NGW, lane);
        }
        if (bx == 0 && tid < 128) {
            const double k = exp2(-(double)tid * (13.287712379549449 / 128.0)) * 0.15915494309189535;
            const float hi = __uint_as_float(__float_as_uint((float)k) & 0xFFFFF000u);
            ropeK[tid] = hi; ropeK[128 + tid] = (float)(k - (double)hi);
        }
        for (int e = bx * 512 + tid; e < (int)(2 * MiB / 16); e += G * 512) ((u32x4*)(GAS u32x4*)(opq(ws) + WS_XCH))[e] = (u32x4){0u, 0u, 0u, 0u};
        rows_to_bf16(x_in, XB, RSTD, NTOK, nullptr, gw, NGW, lane);
        rows_to_bf16(mem, MEMB, MRSTD, NMEM, nullptr, gw, NGW, lane);
    }
    GRID_BAR();
    {
        pg8::Gemm g = pg8::mk_gemm(MEMB, WB + WO_XA_K, 1024, 1024, 1024, 16, 16, 0, 256 * 1024, 0, 30);
        pg8::StaticOrder S; S.init(16, 16, G, bx);
        pg8::EpiStore E{KMEM, 4096, MRSTD, nullptr, 30, 0};
        pg8::gemm_phase(lds, g, S, E);
    }
    {
        pg8::Gemm g = pg8::mk_gemm(MEMB, WB + WO_XA_V, 1024, 1024, 1024, 16, 16, 0, 256 * 1024, 0, 30);
        pg8::StaticOrder S; S.init(16, 16, G, bx);
        pg8::EpiStore E{VTMEM, 4096, MRSTD, nullptr, 30, 0};
        pg8::gemm_phase(lds, g, S, E);
    }
    GRID_BAR();

    unsigned ggen = 0;
    const bool same_xcd = __builtin_popcount((unsigned)__builtin_amdgcn_readfirstlane(xb_ld(ctl + CW_GRP + 64 * (16 + grp)))) == 1;
#define GROUP_BAR() grp_barrier(ctl + CW_GRP + 64 * grp, ggen, same_xcd)
#define SCRB ((unsigned char*)(opq(ws) + WS_MB + (size_t)grp * (40 * MiB)))
#define SCR_ROWS(off, ld) ((bf16_t*)(SCRB + (off)) - (size_t)grp * SEQ * (ld))
#define SCR_BAT(off, per) ((bf16_t*)(SCRB + (off)) - (size_t)grp * (per))
#define XCH_P(rowoff) ((unsigned long long*)(GAS unsigned long long*)(opq(ws) + WS_XCH) + (size_t)(rowoff) * 4)
static_assert(pg8::WGM * 4 * pg8::NXCD == 256, "fused post-norm exchange: with 256 workgroups, WGM * nN(=4) units per (XCD slice, round) must be exactly one 8-panel group, so that a row panel's four column tiles are always dealt in the SAME round (else the owners wait for each other across rounds: deadlock until the spin cap)");
#define FUSED_OUT(GDESC, NM, SUB, PBASE, ROWOFF, GPOST, OUT32) do { \
        pg8::Gemm g = pg8::mk_gemm GDESC; pg8::GroupOrder S; S.init(true, 16, 4, 4, 4, grp, wg16); \
        pg8::EpiNormRes E{XB + (size_t)(ROWOFF) * DM, XB + (size_t)(ROWOFF) * DM, (OUT32), RSTD + (size_t)(ROWOFF) * 4, (GPOST), XCH_P(ROWOFF), (unsigned)((SUB) + 1), lds + SMX_OFF}; \
        pg8::gemm_phase(lds, g, S, E); } while (0)
#pragma unroll 1
    for (int layer = 0; layer < DEPTH; ++layer) {
        const int kind = layer % 3, j = layer / 3;
        if (kind == 0) {
            bf16_t* DP = SCR_ROWS(0, 1024);
            pool_pre(XB, RSTD, n_mix_pre + layer * DM, DP, 64 * grp + wg16, 64 * grp + 64, 16, tid);
            GROUP_BAR();
            FUSED_OUT((DP, WB + WO_POOL + (size_t)j * 262144, 1024, 256, 256, 256, 4, 256, 65536, 0, 30), 256, layer * 3, 0, 0, n_mix_post + layer * DM, nullptr);
        } else if (kind == 1) {
            bf16_t* QK = SCR_ROWS(0, 2048); bf16_t* VT = SCR_BAT(16 * MiB, (size_t)1024 * LDT); bf16_t* AO = SCR_ROWS(25 * MiB, 1024);
            {
                pg8::Gemm g = pg8::mk_gemm(XB, WB + WO_SB_QK, 1024, 1024, 1024, 256, 8, 0, 256 * 1024, 0, 30);
                pg8::GroupOrder S; S.init(true, 16, 8, 4, 4, grp, wg16);
                pg8::EpiStore E{QK, 2048, RSTD, nullptr, 30, 0};
                pg8::gemm_phase(lds, g, S, E);
            }
            {
                pg8::Gemm g = pg8::mk_gemm(WB + WO_SB_V, XB, 1024, 1024, 1024, 4, 256, 0, 256 * 1024, 0, 30);
                pg8::GroupOrder S; S.init(false, 16, 4, 4, 4, grp, wg16);
                pg8::EpiStore E{VT, LDT, nullptr, RSTD, 4, (long)1024 * LDT};
                pg8::gemm_phase(lds, g, S, E);
            }
            GROUP_BAR();
            sb_attention(QK, VT, AO, lds, vcu, G, tid);
            GROUP_BAR();
            FUSED_OUT((AO, WB + WO_SB_O, 1024, 1024, 1024, 256, 4, 0, 256 * 1024, 0, 30), 256, layer * 3, 0, 0, n_mix_post + layer * DM, nullptr);
        } else {
            bf16_t* QKn = (bf16_t*)X; bf16_t* KVT = SCR_BAT(0, (size_t)2048 * LDR); bf16_t* RO = SCR_ROWS(17 * MiB, 2048);
            bf16_t* SC = (bf16_t*)(GAS bf16_t*)(opq(ws) + WS_SC); float* GNS = (float*)(GAS float*)(opq(ws) + WS_MEMB);
            {
                pg8::Gemm g = pg8::mk_gemm(XB, WB + WO_RT_QK, 1024, 1024, 1024, 256, 8, 0, 256 * 1024, 0, 30);
                pg8::GroupOrder S; S.init(true, 16, 8, 4, 4, grp, wg16);
                pg8::EpiRetQK E{QKn, 2048, RSTD, ropeK};
                pg8::gemm_phase(lds, g, S, E);
            }
            {
                pg8::Gemm g = pg8::mk_gemm(WB + WO_RT_KV, XB, 1024, 1024, 1024, 8, 256, 0, 256 * 1024, 0, 30);
                pg8::GroupOrder S; S.init(false, 16, 8, 4, 4, grp, wg16);
                pg8::EpiRetKVT E{KVT, RSTD};
                pg8::gemm_phase(lds, g, S, E);
            }
            GROUP_BAR();
            ret_scores(QKn, SC, 256 * grp + wg16 * 8 + wave, 256 * grp + 256, 128, lane);
            GROUP_BAR();
            ret_scan(QKn, KVT, SC, RO, GNS, lds, vcu, G, tid);
            GROUP_BAR();
            {
                pg8::Gemm g = pg8::mk_gemm(XB, WB + WO_RT_G, 1024, 1024, 1024, 256, 8, 0, 256 * 1024, 0, 30);
                pg8::GroupOrder S; S.init(true, 16, 8, 4, 4, grp, wg16);
                pg8::EpiRetGate E{RO, 2048, RSTD, GNS, ret_gn};
                pg8::gemm_phase(lds, g, S, E);
            }
            GROUP_BAR();
            FUSED_OUT((RO, WB + WO_RT_O, 2048, 2048, 2048, 256, 4, 0, 256 * 2048, 0, 30), 256, layer * 3, 0, 0, n_mix_post + layer * DM, nullptr);
        }
        {
            bf16_t* P = SCR_ROWS(0, 1024); bf16_t* MT = SCR_BAT(34 * MiB, (size_t)1024 * 1024); bf16_t* NT = SCR_BAT(36 * MiB, (size_t)1024 * 1024);
            {
                pg8::Gemm g{KMEM + (size_t)layer * 1024, WB + WO_XA_Q + (size_t)layer * 1048576, 4096, 1024, 256, 64, 4, 2, 30, 256, (long)256 * 4096, 0, 0, 256, 0, (long)256 * 1024, 0};
                pg8::GroupOrder S; S.init(true, 4, 4, 4, 4, grp, wg16);
                pg8::EpiStore E{MT, 1024, nullptr, nullptr, 30, 0};
                pg8::gemm_phase(lds, g, S, E);
            }
            {
                pg8::Gemm g{WB + WO_XA_O + (size_t)layer * 1048576, VTMEM + (size_t)layer * 1024, 1024, 4096, 256, 4, 64, 30, 2, (long)256 * 1024, 0, 256, 0, 0, 0, 256, (long)256 * 4096};
                pg8::GroupOrder S; S.init(false, 4, 4, 4, 4, grp, wg16);
                pg8::EpiStore E{NT, 1024, nullptr, nullptr, 2, (long)1024 * 1024};
                pg8::gemm_phase(lds, g, S, E);
            }
            GROUP_BAR();
            {
                pg8::Gemm g = pg8::mk_gemm(XB, MT, 1024, 1024, 1024, 256, 4, 0, 256 * 1024, (long)1024 * 1024, 4);
                pg8::GroupOrder S; S.init(true, 16, 4, 4, 4, grp, wg16);
                pg8::EpiSoftmax E{P, 1024, (LAS float*)(lds + SMX_OFF), RSTD};
                pg8::gemm_phase(lds, g, S, E);
            }
            GROUP_BAR();
            FUSED_OUT((P, NT, 1024, 1024, 1024, 256, 4, 0, 256 * 1024, (long)1024 * 1024, 4), 256, layer * 3 + 1, 0, 0, n_xa_post + layer * DM, nullptr);
            GROUP_BAR();
        }
        {
            bf16_t* ACT = SCR_ROWS(0, DFF);
            {
                pg8::Gemm g = pg8::mk_gemm(XB, WB + WO_FF_IN + (size_t)layer * 5632 * 1024, 1024, 1024, 1024, 256, 22, 0, 256 * 1024, 0, 30);
                pg8::GroupOrder S; S.init(true, 16, 20, 4, 4, grp, wg16); S.tail0 = 20; S.rounds = 22;
                pg8::EpiSwiglu E{ACT, DFF, RSTD};
                pg8::gemm_phase(lds, g, S, E);
            }
            GROUP_BAR();
            FUSED_OUT((ACT, WB + WO_FF_OUT + (size_t)layer * 1024 * 2816, DFF, DFF, DFF, 256, 4, 0, (long)256 * DFF, 0, 30), 256, layer * 3 + 2, 0, 0, n_ffn_post + layer * DM, (layer == DEPTH - 1 ? X : nullptr));
            GROUP_BAR();
        }
    }
}

extern "C" void kernel_launch(void* const* d_in, const int* in_sizes, int n_in, void* d_out, int out_size, void* d_ws, size_t ws_size, hipStream_t stream) {
    static int grid = 0;
    if (grid == 0) {
        if (n_in != 21 || in_sizes[0] != NTOK * DM || out_size != NTOK * DM || ws_size < WS_END) {
            fprintf(stderr, "kernel_launch: unexpected problem (n_in %d, in0 %d, out %d, ws %zu, need %zu); nothing launched\n", n_in, n_in > 0 ? in_sizes[0] : -1, out_size, ws_size, (size_t)WS_END); grid = -1; return; }
        int dev = 0, cus = 0, per_cu = 0;
        if (hipGetDevice(&dev) != hipSuccess || hipDeviceGetAttribute(&cus, hipDeviceAttributeMultiprocessorCount, dev) != hipSuccess) { grid = -1; return; }
        if (hipFuncSetAttribute((const void*)fwd_kernel, hipFuncAttributeMaxDynamicSharedMemorySize, LDS_BYTES) != hipSuccess) { fprintf(stderr, "kernel_launch: hipFuncSetAttribute failed\n"); grid = -1; return; }
        if (hipOccupancyMaxActiveBlocksPerMultiprocessor(&per_cu, (const void*)fwd_kernel, 512, LDS_BYTES) != hipSuccess || per_cu < 1)
            fprintf(stderr, "kernel_launch: note: occupancy query reports %d workgroups per CU\n", per_cu);
        (void)hipGetLastError();
        if (cus != 256) { fprintf(stderr, "kernel_launch: built for 256 CUs (one 256-unit GEMM round per workgroup in the fused post-norm phases), device has %d; nothing launched\n", cus); grid = -1; return; }
        grid = cus;
    }
    if (grid < 0) return;
    if (hipMemsetAsync((char*)d_ws + WS_CTL, 0, CTL_ZERO_BYTES, stream) != hipSuccess) return;
    Args a{};
    for (int i = 0; i < 21; ++i) a.in[i] = (const float*)d_in[i];
    a.out = (float*)d_out; a.ws = (unsigned char*)d_ws;
    hipLaunchKernelGGL(fwd_kernel, dim3(grid), dim3(512), LDS_BYTES, stream, a);
}
```
